# Optimizing an MI355X kernel written in HIP

```python
import math
import jax, jax.numpy as jnp
from jax import lax
import numpy as np

D_MODEL = 1024
BATCH = 8
SEQ = 4096
DEPTH = 2

CHUNK = 64
N_MIXERS = 2
N_SSM_LAYERS = (DEPTH + N_MIXERS - 1) // N_MIXERS
N_ATTN_LAYERS = DEPTH // N_MIXERS

SSM_GROUP = 16
SSM_GROUPS = D_MODEL // SSM_GROUP
SSM_STATE = 64
DT_MIN = 1e-3
DT_MAX = 1e-1

DIFF_HEAD_DIM = 64
DIFF_HEADS = D_MODEL // (2 * DIFF_HEAD_DIM)
V_HEAD_DIM = 2 * DIFF_HEAD_DIM
ROPE_THETA = 10000.0
Q_BLOCK = 128

N_EXPERT_GROUPS = 4
EXPERTS_PER_GROUP = 8
TOP_K = 2
D_EXPERT = D_MODEL // 4

EPS = 1e-6

kernel_name = "hybrid_s5_diffattn_hiermoe_stream"


def rms_norm(x, g):
    xf = x.astype(jnp.float32)
    y = xf * lax.rsqrt(jnp.mean(xf * xf, axis=-1, keepdims=True) + EPS)
    return (y * g.astype(jnp.float32)).astype(x.dtype)


def rope_tables(seq):
    pos = jnp.arange(seq, dtype=jnp.float32)
    inv = ROPE_THETA ** (-jnp.arange(0, DIFF_HEAD_DIM, 2, dtype=jnp.float32) / DIFF_HEAD_DIM)
    ang = pos[:, None] * inv[None, :]
    return jnp.cos(ang), jnp.sin(ang)


def apply_rope(x, cos, sin):
    half = DIFF_HEAD_DIM // 2
    x1, x2 = x[..., :half], x[..., half:]
    c = cos[None, :, None, None, :].astype(x.dtype)
    s = sin[None, :, None, None, :].astype(x.dtype)
    return jnp.concatenate([x1 * c - x2 * s, x2 * c + x1 * s], axis=-1)


def _scan_op(left, right):
    a_l, b_l = left
    a_r, b_r = right
    return a_r * a_l, a_r * b_l + b_r


def s5_mixer(h, w_in, lam_re, lam_im, log_dt, b_re, b_im, c_re, c_im, d_skip, w_glu):
    bsz, seq, _ = h.shape
    u = (h @ w_in).astype(jnp.float32)
    lam = lax.complex(lam_re.astype(jnp.float32), lam_im.astype(jnp.float32))
    dt = jnp.exp(log_dt.astype(jnp.float32))[:, None]
    lam_bar = jnp.exp(lam * dt)
    b_c = lax.complex(b_re.astype(jnp.float32), b_im.astype(jnp.float32))
    b_bar = ((lam_bar - 1.0) / lam)[..., None] * b_c
    c_c = lax.complex(c_re.astype(jnp.float32), c_im.astype(jnp.float32))
    n_chunks = seq // CHUNK
    u_chunks = u.reshape(bsz, n_chunks, CHUNK, SSM_GROUPS, SSM_GROUP).transpose(1, 0, 2, 3, 4)
    a = jnp.broadcast_to(lam_bar, (bsz, CHUNK, SSM_GROUPS, SSM_STATE))

    def chunk_step(state, u_c):
        bu = jnp.einsum('bcgh,gph->bcgp', u_c.astype(jnp.complex64), b_bar)
        a_cum, x_loc = lax.associative_scan(_scan_op, (a, bu), axis=1)
        xs = x_loc + a_cum * state[:, None]
        y = jnp.real(jnp.einsum('bcgp,ghp->bcgh', xs, c_c))
        return xs[:, -1], y

    state0 = jnp.zeros((bsz, SSM_GROUPS, SSM_STATE), jnp.complex64)
    _, y = lax.scan(chunk_step, state0, u_chunks)
    y = y.transpose(1, 0, 2, 3, 4).reshape(bsz, seq, D_MODEL) + d_skip.astype(jnp.float32) * u
    g = jax.nn.gelu(y).astype(h.dtype)
    val, gate = jnp.split(g @ w_glu, 2, axis=-1)
    return val * jax.nn.sigmoid(gate)


def diff_attention(h, w_qkv, lq1, lk1, lq2, lk2, subln_g, w_o, cos, sin, lambda_init):
    bsz, seq, _ = h.shape
    q, k, v = jnp.split(h @ w_qkv, 3, axis=-1)
    q = q.reshape(bsz, seq, DIFF_HEADS, 2, DIFF_HEAD_DIM)
    k = k.reshape(bsz, seq, DIFF_HEADS, 2, DIFF_HEAD_DIM)
    v32 = v.reshape(bsz, seq, DIFF_HEADS, V_HEAD_DIM).astype(jnp.float32)
    q = apply_rope(q, cos, sin) * (DIFF_HEAD_DIM ** -0.5)
    k = apply_rope(k, cos, sin)
    lam = (jnp.exp(jnp.sum(lq1.astype(jnp.float32) * lk1.astype(jnp.float32)))
           - jnp.exp(jnp.sum(lq2.astype(jnp.float32) * lk2.astype(jnp.float32)))
           + lambda_init)
    key_chunk = jnp.arange(seq) // CHUNK
    n_blocks = seq // Q_BLOCK
    q_blocks = q.reshape(bsz, n_blocks, Q_BLOCK, DIFF_HEADS, 2, DIFF_HEAD_DIM).transpose(1, 0, 2, 3, 4, 5)

    def block(args):
        qb, bi = args
        s = jnp.einsum('bqhcd,bkhcd->bhcqk', qb, k, preferred_element_type=jnp.float32)
        q_chunk = (bi * Q_BLOCK + jnp.arange(Q_BLOCK)) // CHUNK
        mask = key_chunk[None, :] <= q_chunk[:, None]
        s = jnp.where(mask, s, -jnp.inf)
        p = jax.nn.softmax(s, axis=-1)
        attn = p[:, :, 0] - lam * p[:, :, 1]
        o = jnp.einsum('bhqk,bkhe->bqhe', attn, v32)
        o = o * lax.rsqrt(jnp.mean(o * o, axis=-1, keepdims=True) + EPS)
        o = o * subln_g.astype(jnp.float32) * (1.0 - lambda_init)
        return o.astype(h.dtype)

    o = lax.map(block, (q_blocks, jnp.arange(n_blocks)))
    o = o.transpose(1, 0, 2, 3, 4).reshape(bsz, seq, D_MODEL)
    return o @ w_o


def hier_moe(h, w_rg, b_rg, w_re, b_re, w_gate, w_up, w_down):
    bsz, seq, d = h.shape
    t = h.reshape(-1, d)
    gl = (t @ w_rg).astype(jnp.float32)
    gp = jax.nn.softmax(gl, axis=-1)
    g_sel = jnp.argmax(gl + b_rg.astype(jnp.float32), axis=-1)
    g_onehot = jax.nn.one_hot(g_sel, N_EXPERT_GROUPS, dtype=jnp.float32)
    g_w = jnp.sum(gp * g_onehot, axis=-1)
    el = jnp.einsum('td,dge->tge', t, w_re).astype(jnp.float32)
    el_sel = jnp.sum(el * g_onehot[:, :, None], axis=1)
    ep = jax.nn.softmax(el_sel, axis=-1)
    bias_sel = g_onehot @ b_re.astype(jnp.float32)
    _, e_idx = lax.top_k(ep + bias_sel, TOP_K)
    e_w = jnp.take_along_axis(ep, e_idx, axis=-1)
    e_w = e_w / jnp.sum(e_w, axis=-1, keepdims=True)
    within = jnp.sum(jax.nn.one_hot(e_idx, EXPERTS_PER_GROUP, dtype=jnp.float32) * e_w[..., None], axis=1)
    combine = (g_onehot[:, :, None] * within[:, None, :] * g_w[:, None, None]).astype(t.dtype)
    out = jnp.zeros_like(t)
    for g in range(N_EXPERT_GROUPS):
        gate = jnp.einsum('td,edf->tef', t, w_gate[g])
        up = jnp.einsum('td,edf->tef', t, w_up[g])
        hid = jax.nn.silu(gate) * up * combine[:, g, :, None]
        out = out + jnp.einsum('tef,efd->td', hid, w_down[g])
    return out.reshape(bsz, seq, d)


def setup_inputs(seed: int = 0) -> dict:
    key = jax.random.key(seed)
    ks = jax.random.split(key, 32)
    f32 = jnp.float32

    def nrm(k, shape, scale):
        return jax.random.normal(k, shape, f32) * scale

    NA, NB, L = N_SSM_LAYERS, N_ATTN_LAYERS, DEPTH
    G, P, HG = SSM_GROUPS, SSM_STATE, SSM_GROUP
    NG, NE, F = N_EXPERT_GROUPS, EXPERTS_PER_GROUP, D_EXPERT
    D = D_MODEL
    n_idx = jnp.arange(P, dtype=f32)
    return {
        'x': nrm(ks[0], (BATCH, SEQ, D), 1.0),
        'norm_mix_g': 1.0 + nrm(ks[1], (L, D), 0.02),
        'norm_ffn_g': 1.0 + nrm(ks[2], (L, D), 0.02),
        'final_norm_g': 1.0 + nrm(ks[3], (D,), 0.02),
        'ssm_w_in': nrm(ks[4], (NA, D, D), D ** -0.5),
        'ssm_lam_re': -0.5 + nrm(ks[5], (NA, G, P), 0.01),
        'ssm_lam_im': math.pi * n_idx + nrm(ks[6], (NA, G, P), 0.01),
        'ssm_log_dt': jax.random.uniform(ks[7], (NA, G), f32, math.log(DT_MIN), math.log(DT_MAX)),
        'ssm_b_re': nrm(ks[8], (NA, G, P, HG), (0.5 / HG) ** 0.5),
        'ssm_b_im': nrm(ks[9], (NA, G, P, HG), (0.5 / HG) ** 0.5),
        'ssm_c_re': nrm(ks[10], (NA, G, HG, P), (0.5 / P) ** 0.5),
        'ssm_c_im': nrm(ks[11], (NA, G, HG, P), (0.5 / P) ** 0.5),
        'ssm_d': nrm(ks[12], (NA, D), 1.0),
        'ssm_w_glu': nrm(ks[13], (NA, D, 2 * D), D ** -0.5),
        'attn_w_qkv': nrm(ks[14], (NB, D, 3 * D), D ** -0.5),
        'attn_lambda_q1': nrm(ks[15], (NB, DIFF_HEAD_DIM), 0.1),
        'attn_lambda_k1': nrm(ks[16], (NB, DIFF_HEAD_DIM), 0.1),
        'attn_lambda_q2': nrm(ks[17], (NB, DIFF_HEAD_DIM), 0.1),
        'attn_lambda_k2': nrm(ks[18], (NB, DIFF_HEAD_DIM), 0.1),
        'attn_subln_g': 1.0 + nrm(ks[19], (NB, V_HEAD_DIM), 0.02),
        'attn_w_o': nrm(ks[20], (NB, D, D), D ** -0.5),
        'moe_w_router_group': nrm(ks[21], (L, D, NG), D ** -0.5),
        'moe_b_router_group': nrm(ks[22], (L, NG), 0.01),
        'moe_w_router_expert': nrm(ks[23], (L, D, NG, NE), D ** -0.5),
        'moe_b_router_expert': nrm(ks[24], (L, NG, NE), 0.01),
        'moe_w_gate': nrm(ks[25], (L, NG, NE, D, F), D ** -0.5),
        'moe_w_up': nrm(ks[26], (L, NG, NE, D, F), D ** -0.5),
        'moe_w_down': nrm(ks[27], (L, NG, NE, F, D), F ** -0.5),
    }


def reference(x, norm_mix_g, norm_ffn_g, final_norm_g,
              ssm_w_in, ssm_lam_re, ssm_lam_im, ssm_log_dt, ssm_b_re, ssm_b_im,
              ssm_c_re, ssm_c_im, ssm_d, ssm_w_glu,
              attn_w_qkv, attn_lambda_q1, attn_lambda_k1, attn_lambda_q2, attn_lambda_k2,
              attn_subln_g, attn_w_o,
              moe_w_router_group, moe_b_router_group, moe_w_router_expert, moe_b_router_expert,
              moe_w_gate, moe_w_up, moe_w_down):
    cos, sin = rope_tables(x.shape[1])
    for i in range(DEPTH):
        h = rms_norm(x, norm_mix_g[i])
        j = i // N_MIXERS
        if i % N_MIXERS == 0:
            mix = s5_mixer(h, ssm_w_in[j], ssm_lam_re[j], ssm_lam_im[j], ssm_log_dt[j],
                           ssm_b_re[j], ssm_b_im[j], ssm_c_re[j], ssm_c_im[j], ssm_d[j], ssm_w_glu[j])
        else:
            lambda_init = 0.8 - 0.6 * math.exp(-0.3 * i)
            mix = diff_attention(h, attn_w_qkv[j], attn_lambda_q1[j], attn_lambda_k1[j],
                                 attn_lambda_q2[j], attn_lambda_k2[j], attn_subln_g[j], attn_w_o[j],
                                 cos, sin, lambda_init)
        x = x + mix
        h = rms_norm(x, norm_ffn_g[i])
        x = x + hier_moe(h, moe_w_router_group[i], moe_b_router_group[i], moe_w_router_expert[i],
                         moe_b_router_expert[i], moe_w_gate[i], moe_w_up[i], moe_w_down[i])
    return rms_norm(x, final_norm_g)
```

```cpp
#include <hip/hip_runtime.h>
#include <cstdio>
#include <cstdint>
#include <cmath>

typedef unsigned short bf16;
typedef float f32x4 __attribute__((ext_vector_type(4)));
typedef unsigned u32x4 __attribute__((ext_vector_type(4)));

constexpr int NB = 8, SEQ = 4096, T = NB * SEQ, D = 1024;
constexpr int SG = 64, SP = 64, SH = 16, CS = 16, NCR = T / CS, UXP = 384;
constexpr int NH = 8, HD = 64, VD = 128;
constexpr int NE = 32, FE = 256;
constexpr float EPS = 1e-6f;
constexpr float LOG2E = 1.4426950408889634f;
constexpr float QSCALE = 0.125f * LOG2E;

constexpr size_t MiB = 1u << 20;
constexpr size_t WS_CTL = 0, CTL_ZERO_BYTES = 1 * MiB;
constexpr size_t WS_CONST = 1 * MiB;
constexpr size_t WS_ROPE = 2 * MiB;
constexpr size_t WS_WIN = 4 * MiB, WS_WGLU = 6 * MiB, WS_WQKV = 10 * MiB, WS_WO = 16 * MiB;
constexpr size_t WS_MG = 18 * MiB;
constexpr size_t WS_TE = 22 * MiB;
constexpr size_t WS_WGU = 34 * MiB;
constexpr size_t WS_WD = 98 * MiB;
constexpr size_t WS_LIST = 130 * MiB;
constexpr size_t WS_R1 = 138 * MiB;
constexpr size_t WS_R2 = 202 * MiB;
constexpr size_t WS_R3 = 330 * MiB;
constexpr size_t WS_END = 394 * MiB;
constexpr int CW_CNT = 16384;

struct Params { const float* in[28]; float* out; unsigned char* ws; };

__device__ __forceinline__ unsigned f2bf(float f) { unsigned u = __builtin_bit_cast(unsigned, f); return (u + 0x7fffu + ((u >> 16) & 1u)) >> 16; }
__device__ __forceinline__ float bf2f(unsigned b) { return __builtin_bit_cast(float, b << 16); }
__device__ __forceinline__ unsigned pk2(float lo, float hi) { return f2bf(lo) | (f2bf(hi) << 16); }
__device__ __forceinline__ u32x4 pack8(const float* v) { u32x4 w; w.x = pk2(v[0], v[1]); w.y = pk2(v[2], v[3]); w.z = pk2(v[4], v[5]); w.w = pk2(v[6], v[7]); return w; }
__device__ __forceinline__ void unpack8(u32x4 w, float* v) { v[0] = bf2f(w.x & 0xffffu); v[1] = bf2f(w.x >> 16); v[2] = bf2f(w.y & 0xffffu); v[3] = bf2f(w.y >> 16);
    v[4] = bf2f(w.z & 0xffffu); v[5] = bf2f(w.z >> 16); v[6] = bf2f(w.w & 0xffffu); v[7] = bf2f(w.w >> 16); }
__device__ __forceinline__ float wave_sum(float v) {
#pragma unroll
    for (int o = 1; o < 64; o <<= 1) v += __shfl_xor(v, o);
    return v;
}
__device__ __forceinline__ float gelu_tanh(float x) { const float u = 0.7978845608028654f * (x + 0.044715f * x * x * x); const float e = __expf(2.f * u); const float th = 1.f - 2.f / (e + 1.f); return 0.5f * x * (1.f + th); }
__device__ __forceinline__ float sigmoidf_(float x) { return 1.f / (1.f + __expf(-x)); }

struct GUnit { int pm, pn, e, aux, cnt, pad; };

struct SchedDense {
    const bf16* A; const bf16* Bt; int nN, K, amode, pad;
    static constexpr int NHALF = 2;
    __device__ __forceinline__ int total() const { return (T / 256) * nN; }
    __device__ __forceinline__ bool get(int idx, GUnit& u) const { if (idx >= total()) return false; u.pm = idx / nN; u.pn = idx % nN; u.e = 0; u.aux = 0; u.cnt = 256; u.pad = 0; return true; }
    __device__ __forceinline__ const bf16* a8(const GUnit& u, int r, int k) const { const size_t t = (size_t)u.pm * 256 + r;
        return amode == 0 ? A + t * K + k : A + ((size_t)(k >> 4) * T + t) * 16 + (k & 15); }
    __device__ __forceinline__ const bf16* bbase(const GUnit& u) const { return Bt + (size_t)u.pn * 256 * K; }
};
template <int NHALF_> struct SchedSsm {
    const bf16* UX; const bf16* Bt; int K, brows;
    static constexpr int NHALF = NHALF_;
    __device__ __forceinline__ int total() const { return SG * (NCR / 256); }
    __device__ __forceinline__ bool get(int idx, GUnit& u) const { if (idx >= total()) return false; u.e = idx / (NCR / 256); u.pm = idx % (NCR / 256); u.pn = 0; u.aux = 0; u.cnt = 256; u.pad = 0; return true; }
    __device__ __forceinline__ const bf16* a8(const GUnit& u, int r, int k) const { return UX + ((size_t)u.e * NCR + (size_t)u.pm * 256 + r) * UXP + k; }
    __device__ __forceinline__ const bf16* bbase(const GUnit& u) const { return Bt + (size_t)u.e * brows * K; }
};
template <int PHASE> struct SchedMoe {
    const bf16* A; const bf16* Bt; const unsigned* cnt; const int* list;
    static constexpr int NHALF = 2;
    static constexpr int NPN = PHASE == 1 ? 2 : 4, K = PHASE == 1 ? 1024 : 256, BROWS = PHASE == 1 ? 512 : 1024;
    __device__ __forceinline__ bool get(int idx, GUnit& u) const {
        int j = idx / NPN; u.pn = idx % NPN; int prefix = 0;
        for (int e = 0; e < NE; ++e) { const int c = (int)cnt[e * 64]; const int nt = (c + 255) >> 8;
            if (j < nt) { u.e = e; u.pm = j; u.aux = (prefix + j) * 256; u.cnt = c; u.pad = 0; return true; }
            j -= nt; prefix += nt; }
        return false;
    }
    __device__ __forceinline__ const bf16* a8(const GUnit& u, int r, int k) const {
        if (PHASE == 1) { const int ri = u.pm * 256 + r; const int tok = ri < u.cnt ? (list[(size_t)u.e * T + ri] >> 1) : 0; return A + (size_t)tok * D + k; }
        return A + ((size_t)u.aux + r) * FE + k;
    }
    __device__ __forceinline__ const bf16* bbase(const GUnit& u) const { return Bt + ((size_t)u.e * BROWS + (size_t)u.pn * 256) * K; }
};

struct EpiWin { bf16* UX;
    __device__ __forceinline__ void operator()(const GUnit& u, int r, int wc, int fq, const float (&v0)[8], const float (&v1)[8]) const {
        const int t = u.pm * 256 + r, n = t >> 4, s = t & 15;
#pragma unroll
        for (int hb = 0; hb < 2; ++hb) { const int c = u.pn * 256 + hb * 128 + wc * 32 + fq * 8, g = c >> 4, hh = c & 15;
            *(u32x4*)(UX + ((size_t)g * NCR + n) * UXP + s * 16 + hh) = pack8(hb ? v1 : v0); }
    } };
struct EpiSsmA { float* SLOC;
    __device__ __forceinline__ void operator()(const GUnit& u, int r, int wc, int fq, const float (&v0)[8], const float (&v1)[8]) const {
        float* o = SLOC + ((size_t)u.e * NCR + (size_t)u.pm * 256 + r) * 128 + wc * 32 + fq * 8;
        *(f32x4*)o = (f32x4){v0[0], v0[1], v0[2], v0[3]}; *(f32x4*)(o + 4) = (f32x4){v0[4], v0[5], v0[6], v0[7]};
    } };
struct EpiSsmC { bf16* G;
    __device__ __forceinline__ void operator()(const GUnit& u, int r, int wc, int fq, const float (&v0)[8], const float (&v1)[8]) const {
        const int n = u.pm * 256 + r;
#pragma unroll
        for (int hb = 0; hb < 2; ++hb) { const int j = hb * 128 + wc * 32 + fq * 8, tt = j >> 4, ho = j & 15; const size_t tok = (size_t)n * 16 + tt;
            float g[8];
#pragma unroll
            for (int i = 0; i < 8; ++i) g[i] = gelu_tanh(hb ? v1[i] : v0[i]);
            *(u32x4*)(G + ((size_t)u.e * T + tok) * 16 + ho) = pack8(g); }
    } };
struct EpiGlu { const float* xin; float* X;
    __device__ __forceinline__ void operator()(const GUnit& u, int r, int wc, int fq, const float (&v0)[8], const float (&v1)[8]) const {
        const size_t o = ((size_t)u.pm * 256 + r) * D + u.pn * 128 + wc * 32 + fq * 8;
        const f32x4 a = *(const f32x4*)(xin + o), b = *(const f32x4*)(xin + o + 4);
        float m[8];
#pragma unroll
        for (int i = 0; i < 8; ++i) m[i] = v0[i] * sigmoidf_(v1[i]);
        *(f32x4*)(X + o) = (f32x4){a.x + m[0], a.y + m[1], a.z + m[2], a.w + m[3]}; *(f32x4*)(X + o + 4) = (f32x4){b.x + m[4], b.y + m[5], b.z + m[6], b.w + m[7]};
    } };
struct EpiMoe1 { bf16* HID; const float* wl;
    __device__ __forceinline__ void operator()(const GUnit& u, int r, int wc, int fq, const float (&v0)[8], const float (&v1)[8]) const {
        const int ri = u.pm * 256 + r; const float w = ri < u.cnt ? wl[(size_t)u.e * T + ri] : 0.f;
        float h[8];
#pragma unroll
        for (int i = 0; i < 8; ++i) h[i] = v0[i] * sigmoidf_(v0[i]) * v1[i] * w;
        *(u32x4*)(HID + ((size_t)u.aux + r) * FE + u.pn * 128 + wc * 32 + fq * 8) = pack8(h);
    } };
struct EpiMoe2 { bf16* CBUF; const int* list;
    __device__ __forceinline__ void operator()(const GUnit& u, int r, int wc, int fq, const float (&v0)[8], const float (&v1)[8]) const {
        const int ri = u.pm * 256 + r; if (ri >= u.cnt) return;
        const int ent = list[(size_t)u.e * T + ri]; const size_t tok = ent >> 1, slot = ent & 1;
        bf16* o = CBUF + (slot * T + tok) * D + u.pn * 256 + wc * 32 + fq * 8;
        *(u32x4*)o = pack8(v0); *(u32x4*)(o + 128) = pack8(v1);
    } };
struct EpiQkv { bf16* Q; bf16* KIMG; bf16* VIMG; const float* ropec; const float* ropes;
    __device__ __forceinline__ void operator()(const GUnit& u, int r, int wc, int fq, const float (&v0)[8], const float (&v1)[8]) const {
        const int t = u.pm * 256 + r, pos = t & (SEQ - 1), b = t >> 12;
        if (u.pn < 8) {
            const f32x4 c0 = *(const f32x4*)(ropec + pos * 32 + fq * 8), c1 = *(const f32x4*)(ropec + pos * 32 + fq * 8 + 4);
            const f32x4 s0 = *(const f32x4*)(ropes + pos * 32 + fq * 8), s1 = *(const f32x4*)(ropes + pos * 32 + fq * 8 + 4);
            const float cs[8] = {c0.x, c0.y, c0.z, c0.w, c1.x, c1.y, c1.z, c1.w}, sn[8] = {s0.x, s0.y, s0.z, s0.w, s1.x, s1.y, s1.z, s1.w};
            const float sc = u.pn < 4 ? QSCALE : 1.f;
            float o1[8], o2[8];
#pragma unroll
            for (int i = 0; i < 8; ++i) { o1[i] = (v0[i] * cs[i] - v1[i] * sn[i]) * sc; o2[i] = (v1[i] * cs[i] + v0[i] * sn[i]) * sc; }
            const int head = 2 * (u.pn & 3) + (wc >> 1), c = wc & 1;
            if (u.pn < 4) { bf16* o = Q + (size_t)t * D + head * 128 + c * 64 + fq * 8; *(u32x4*)o = pack8(o1); *(u32x4*)(o + 32) = pack8(o2); }
            else { bf16* o = KIMG + (((size_t)(b * NH + head) * 64 + (pos >> 6)) * 8192) + (size_t)(c * 8 + fq) * 512 + (pos & 63) * 8;
                *(u32x4*)o = pack8(o1); *(u32x4*)(o + 4 * 512) = pack8(o2); }
        } else {
#pragma unroll
            for (int hb = 0; hb < 2; ++hb) { const int head = 2 * (u.pn - 8) + hb;
                bf16* o = VIMG + (((size_t)(b * NH + head) * 64 + (pos >> 6)) * 8192) + wc * 2048 + ((pos & 63) >> 4) * 512 + (pos & 15) * 32 + fq * 8;
                *(u32x4*)o = pack8(hb ? v1 : v0); }
        }
    } };
struct EpiWo { float* X;
    __device__ __forceinline__ void operator()(const GUnit& u, int r, int wc, int fq, const float (&v0)[8], const float (&v1)[8]) const {
        float* o = X + ((size_t)u.pm * 256 + r) * D + u.pn * 256 + wc * 32 + fq * 8;
#pragma unroll
        for (int hb = 0; hb < 2; ++hb) { float* p = o + hb * 128; const float* v = hb ? v1 : v0; f32x4 a = *(f32x4*)p, b = *(f32x4*)(p + 4);
            a.x += v[0]; a.y += v[1]; a.z += v[2]; a.w += v[3]; b.x += v[4]; b.y += v[5]; b.z += v[6]; b.w += v[7]; *(f32x4*)p = a; *(f32x4*)(p + 4) = b; }
    } };

template <class Sched, class Epi>
__global__ void __launch_bounds__(256) k_naive_gemm(Sched S, Epi E, int K) {
    GUnit u; if (!S.get(blockIdx.x >> 4, u)) return;
    const int tid = threadIdx.x, r = (blockIdx.x & 15) * 16 + (tid >> 4), pos = tid & 15, wc = pos >> 2, fq = pos & 3;
    const bf16* bb = S.bbase(u) + (size_t)(wc * 32 + fq * 8) * K;
    float v0[8], v1[8];
#pragma unroll
    for (int j = 0; j < 8; ++j) { v0[j] = 0.f; v1[j] = 0.f; }
    for (int k = 0; k < K; k += 8) {
        float a[8]; unpack8(*(const u32x4*)S.a8(u, r, k), a);
#pragma unroll
        for (int j = 0; j < 8; ++j) {
            float b[8]; unpack8(*(const u32x4*)(bb + (size_t)j * K + k), b);
#pragma unroll
            for (int i = 0; i < 8; ++i) v0[j] += a[i] * b[i];
            if (Sched::NHALF == 2) { unpack8(*(const u32x4*)(bb + (size_t)(128 + j) * K + k), b);
#pragma unroll
                for (int i = 0; i < 8; ++i) v1[j] += a[i] * b[i]; }
        }
    }
    E(u, r, wc, fq, v0, v1);
}

__global__ void __launch_bounds__(512) k_ssm_const(Params p) {
    __shared__ float POWr[SP][17], POWi[SP][17], BBr[SP][SH], BBi[SP][SH], KT[16][16][16];
    const int g = blockIdx.x, tid = threadIdx.x;
    const float *lam_re = p.in[5], *lam_im = p.in[6], *log_dt = p.in[7], *b_re = p.in[8], *b_im = p.in[9], *c_re = p.in[10], *c_im = p.in[11], *dsk = p.in[12];
    const double dt = exp((double)log_dt[g]);
    for (int i = tid; i < SP * 17; i += 512) { const int pp = i / 17, k = i % 17; const double re = lam_re[g * SP + pp], im = lam_im[g * SP + pp];
        const double mag = exp(re * dt * k), ang = im * dt * k; POWr[pp][k] = (float)(mag * cos(ang)); POWi[pp][k] = (float)(mag * sin(ang)); }
    for (int i = tid; i < SP * SH; i += 512) { const int pp = i / SH, h = i % SH; const double re = lam_re[g * SP + pp], im = lam_im[g * SP + pp];
        const double mag = exp(re * dt), ang = im * dt; const double lr = mag * cos(ang) - 1.0, li = mag * sin(ang);
        const double den = re * re + im * im; const double cr = (lr * re + li * im) / den, ci = (li * re - lr * im) / den;
        const double br = b_re[(g * SP + pp) * SH + h], bi = b_im[(g * SP + pp) * SH + h];
        BBr[pp][h] = (float)(cr * br - ci * bi); BBi[pp][h] = (float)(cr * bi + ci * br); }
    __syncthreads();
    for (int i = tid; i < 4096; i += 512) { const int tau = i >> 8, ho = (i >> 4) & 15, hi = i & 15; float s = 0.f;
        for (int pp = 0; pp < SP; ++pp) { const float cr = c_re[(g * SH + ho) * SP + pp], ci = c_im[(g * SH + ho) * SP + pp];
            const float zr = POWr[pp][tau], zi = POWi[pp][tau]; const float czr = cr * zr - ci * zi, czi = cr * zi + ci * zr;
            s += czr * BBr[pp][hi] - czi * BBi[pp][hi]; }
        KT[tau][ho][hi] = s; }
    if (tid < SP) { float* L16 = (float*)(p.ws + WS_CONST); L16[(g * SP + tid) * 2] = POWr[tid][16]; L16[(g * SP + tid) * 2 + 1] = POWi[tid][16]; }
    __syncthreads();
    bf16* MG = (bf16*)(p.ws + WS_MG) + (size_t)g * 128 * 256;
    for (int i = tid; i < 128 * 256; i += 512) { const int j = i >> 8, k = i & 255, ri = j >> 6, pp = j & 63, s = k >> 4, h = k & 15;
        const float zr = POWr[pp][15 - s], zi = POWi[pp][15 - s]; const float vr = zr * BBr[pp][h] - zi * BBi[pp][h], vi = zr * BBi[pp][h] + zi * BBr[pp][h];
        MG[i] = (bf16)f2bf(ri ? vi : vr); }
    bf16* TE = (bf16*)(p.ws + WS_TE) + (size_t)g * 256 * 384;
    for (int i = tid; i < 256 * 384; i += 512) { const int j = i / 384, k = i % 384, tt = j >> 4, ho = j & 15; float v;
        if (k < 256) { const int s = k >> 4, hi = k & 15; v = s <= tt ? KT[tt - s][ho][hi] : 0.f; if (s == tt && hi == ho) v += dsk[g * SH + ho]; }
        else { const int kk = k - 256, ri = kk >> 6, pp = kk & 63; const float cr = c_re[(g * SH + ho) * SP + pp], ci = c_im[(g * SH + ho) * SP + pp];
            const float zr = POWr[pp][tt + 1], zi = POWi[pp][tt + 1]; v = ri ? -(cr * zi + ci * zr) : (cr * zr - ci * zi); }
        TE[i] = (bf16)f2bf(v); }
}
__global__ void k_misc_const(Params p) {
    const int i = blockIdx.x * blockDim.x + threadIdx.x;
    float* rc = (float*)(p.ws + WS_ROPE); float* rs = rc + SEQ * 32;
    if (i < SEQ * 32) { const int pos = i >> 5, f = i & 31; const float inv = (float)pow(10000.0, -(double)f / 32.0); const float ang = (float)pos * inv;
        rc[i] = (float)cos((double)ang); rs[i] = (float)sin((double)ang); }
    if (i == 0) { double s1 = 0, s2 = 0; for (int d = 0; d < HD; ++d) { s1 += (double)p.in[15][d] * p.in[16][d]; s2 += (double)p.in[17][d] * p.in[18][d]; }
        const double lam_init = 0.8 - 0.6 * exp(-0.3 * 1.0); float* c = (float*)(p.ws + WS_CONST + 65536); c[0] = (float)(exp(s1) - exp(s2) + lam_init); c[1] = (float)(1.0 - lam_init); }
}

__device__ __forceinline__ void transpose_item(const float* W, int ldw, int scol0, bf16* WT, int K, int drow0, int k0, float* scr, int lane) {
#pragma unroll 8
    for (int i = 0; i < 32; ++i) { const int kk = 2 * i + (lane >> 5); scr[kk * 33 + (lane & 31)] = W[(size_t)(k0 + kk) * ldw + scol0 + (lane & 31)]; }
    __builtin_amdgcn_s_waitcnt(0xc07f); asm volatile("" ::: "memory");
    const int c = lane & 7;
#pragma unroll
    for (int j = 0; j < 4; ++j) { const int n = (lane >> 3) + 8 * j; const float* s = scr + (8 * c) * 33 + n;
        u32x4 o; o.x = pk2(s[0 * 33], s[1 * 33]); o.y = pk2(s[2 * 33], s[3 * 33]); o.z = pk2(s[4 * 33], s[5 * 33]); o.w = pk2(s[6 * 33], s[7 * 33]);
        *(u32x4*)(WT + (size_t)(drow0 + n) * K + k0 + 8 * c) = o; }
    __builtin_amdgcn_s_waitcnt(0xc07f); asm volatile("" ::: "memory");
}
constexpr int CI_WIN = 16 * 32, CI_GLU = 16 * 64, CI_QKV = 16 * 96, CI_WO = 16 * 32, CI_GU = 64 * 16 * 16, CI_WD = 64 * 4 * 32;
constexpr int CI_TOTAL = CI_WIN + CI_GLU + CI_QKV + CI_WO + CI_GU + CI_WD;
__device__ __forceinline__ void conv_item(const Params& p, int it, float* scr, int lane) {
    unsigned char* ws = p.ws;
    if (it < CI_WIN) { const int kb = it / 32, nb = it % 32; transpose_item(p.in[4], D, nb * 32, (bf16*)(ws + WS_WIN), D, nb * 32, kb * 64, scr, lane); return; } it -= CI_WIN;
    if (it < CI_GLU) { const int kb = it / 64, nb = it % 64; const int pn = nb >> 3, bj = (nb >> 2) & 1, i0 = (nb & 3) * 32;
        transpose_item(p.in[13], 2 * D, bj * D + pn * 128 + i0, (bf16*)(ws + WS_WGLU), D, nb * 32, kb * 64, scr, lane); return; } it -= CI_GLU;
    if (it < CI_QKV) { const int kb = it / 96, nb = it % 96; int sc = nb * 32; if (nb < 64) { const int pn = nb >> 3, bj = (nb >> 2) & 1, wc = nb & 3; sc = pn * 256 + wc * 64 + bj * 32; }
        transpose_item(p.in[14], 3 * D, sc, (bf16*)(ws + WS_WQKV), D, nb * 32, kb * 64, scr, lane); return; } it -= CI_QKV;
    if (it < CI_WO) { const int kb = it / 32, nb = it % 32; transpose_item(p.in[20], D, nb * 32, (bf16*)(ws + WS_WO), D, nb * 32, kb * 64, scr, lane); return; } it -= CI_WO;
    if (it < CI_GU) { const int le = it >> 8, r = it & 255, kb = r >> 4, nb = r & 15; const int pn = nb >> 3, bj = (nb >> 2) & 1, i0 = (nb & 3) * 32;
        const float* src = (bj ? p.in[26] : p.in[25]) + (size_t)le * D * FE;
        transpose_item(src, FE, pn * 128 + i0, (bf16*)(ws + WS_WGU) + (size_t)le * 512 * D, D, nb * 32, kb * 64, scr, lane); return; } it -= CI_GU;
    { const int le = it >> 7, r = it & 127, kb = r >> 5, nb = r & 31;
        transpose_item(p.in[27] + (size_t)le * FE * D, D, nb * 32, (bf16*)(ws + WS_WD) + (size_t)le * D * FE, FE, nb * 32, kb * 64, scr, lane); }
}
__global__ void __launch_bounds__(512) k_conv(Params p) {
    __shared__ float scr_all[8][64 * 33];
    const int wave = threadIdx.x >> 6, lane = threadIdx.x & 63, gw = blockIdx.x * 8 + wave, ngw = gridDim.x * 8;
    for (int it = gw; it < CI_TOTAL; it += ngw) conv_item(p, it, scr_all[wave], lane);
}

template <int MODE>
__device__ __forceinline__ void norm_row(const Params& p, int row, int lane) {
    unsigned char* ws = p.ws; constexpr int l = (MODE == 3) ? 1 : 0;
    const float* src = (MODE == 0) ? p.in[0] : p.out; const float* gain = MODE == 0 ? p.in[1] : MODE == 2 ? p.in[1] + D : MODE == 4 ? p.in[3] : p.in[2] + l * D;
    const f32x4* xr = (const f32x4*)(src + (size_t)row * D) + lane;
    f32x4 v[4]; float s = 0.f;
#pragma unroll
    for (int j = 0; j < 4; ++j) v[j] = xr[64 * j];
    if (MODE == 2 || MODE == 4) {
        const bf16* C0 = (const bf16*)(ws + WS_R2) + (size_t)row * D, *C1 = C0 + (size_t)T * D;
#pragma unroll
        for (int j = 0; j < 4; ++j) { const uint2 a = *((const uint2*)C0 + lane + 64 * j), b = *((const uint2*)C1 + lane + 64 * j);
            v[j].x += bf2f(a.x & 0xffffu) + bf2f(b.x & 0xffffu); v[j].y += bf2f(a.x >> 16) + bf2f(b.x >> 16); v[j].z += bf2f(a.y & 0xffffu) + bf2f(b.y & 0xffffu); v[j].w += bf2f(a.y >> 16) + bf2f(b.y >> 16); }
        if (MODE == 2) {
#pragma unroll
            for (int j = 0; j < 4; ++j) ((f32x4*)(p.out + (size_t)row * D) + lane)[64 * j] = v[j]; }
    }
#pragma unroll
    for (int j = 0; j < 4; ++j) s += (v[j].x * v[j].x + v[j].y * v[j].y) + (v[j].z * v[j].z + v[j].w * v[j].w);
    const float rstd = 1.f / sqrtf(wave_sum(s) * (1.f / D) + EPS);
#pragma unroll
    for (int j = 0; j < 4; ++j) { const f32x4 g = ((const f32x4*)gain + lane)[64 * j]; v[j] = v[j] * rstd * g; }
    if (MODE == 4) {
#pragma unroll
        for (int j = 0; j < 4; ++j) ((f32x4*)(p.out + (size_t)row * D) + lane)[64 * j] = v[j];
        return; }
    uint2* o8 = (uint2*)((bf16*)(ws + WS_R1) + (size_t)row * D) + lane;
#pragma unroll
    for (int j = 0; j < 4; ++j) { uint2 o; o.x = pk2(v[j].x, v[j].y); o.y = pk2(v[j].z, v[j].w); o8[64 * j] = o; }
    if (MODE == 1 || MODE == 3) {
        const float* wrg = p.in[21] + (size_t)l * D * 4; const float* wre = p.in[23] + (size_t)l * D * 32; const float* brg = p.in[22] + l * 4; const float* bre = p.in[24] + l * 32;
        float gl[4] = {0.f, 0.f, 0.f, 0.f};
#pragma unroll
        for (int j = 0; j < 4; ++j) { const float xv[4] = {v[j].x, v[j].y, v[j].z, v[j].w};
#pragma unroll
            for (int i = 0; i < 4; ++i) { const int d = 256 * j + 4 * lane + i; const f32x4 w = *(const f32x4*)(wrg + d * 4); gl[0] += xv[i] * w.x; gl[1] += xv[i] * w.y; gl[2] += xv[i] * w.z; gl[3] += xv[i] * w.w; } }
#pragma unroll
        for (int i = 0; i < 4; ++i) gl[i] = wave_sum(gl[i]);
        int gs = 0; float best = gl[0] + brg[0];
#pragma unroll
        for (int i = 1; i < 4; ++i) { const float c = gl[i] + brg[i]; if (c > best) { best = c; gs = i; } }
        const float gm = fmaxf(fmaxf(gl[0], gl[1]), fmaxf(gl[2], gl[3])); float gsum = 0.f, gsel = 0.f;
#pragma unroll
        for (int i = 0; i < 4; ++i) { const float e = __expf(gl[i] - gm); gsum += e; if (i == gs) gsel = e; }
        const float g_w = gsel / gsum;
        float el[8] = {0.f, 0.f, 0.f, 0.f, 0.f, 0.f, 0.f, 0.f};
#pragma unroll
        for (int j = 0; j < 4; ++j) { const float xv[4] = {v[j].x, v[j].y, v[j].z, v[j].w};
#pragma unroll
            for (int i = 0; i < 4; ++i) { const int d = 256 * j + 4 * lane + i; const f32x4 w0 = *(const f32x4*)(wre + d * 32 + gs * 8), w1 = *(const f32x4*)(wre + d * 32 + gs * 8 + 4);
                el[0] += xv[i] * w0.x; el[1] += xv[i] * w0.y; el[2] += xv[i] * w0.z; el[3] += xv[i] * w0.w; el[4] += xv[i] * w1.x; el[5] += xv[i] * w1.y; el[6] += xv[i] * w1.z; el[7] += xv[i] * w1.w; } }
#pragma unroll
        for (int i = 0; i < 8; ++i) el[i] = wave_sum(el[i]);
        float em = el[0];
#pragma unroll
        for (int i = 1; i < 8; ++i) em = fmaxf(em, el[i]);
        float ep[8], esum = 0.f;
#pragma unroll
        for (int i = 0; i < 8; ++i) { ep[i] = __expf(el[i] - em); esum += ep[i]; }
        int e0 = 0, e1 = 0; float b0 = -1e30f, b1 = -1e30f;
#pragma unroll
        for (int i = 0; i < 8; ++i) { ep[i] /= esum; const float c = ep[i] + bre[gs * 8 + i]; if (c > b0) { b0 = c; e0 = i; } }
#pragma unroll
        for (int i = 0; i < 8; ++i) { const float c = ep[i] + bre[gs * 8 + i]; if (i != e0 && c > b1) { b1 = c; e1 = i; } }
        float p0 = 0.f, p1 = 0.f;
#pragma unroll
        for (int i = 0; i < 8; ++i) { if (i == e0) p0 = ep[i]; if (i == e1) p1 = ep[i]; }
        const float w0 = p0 / (p0 + p1) * g_w, w1 = p1 / (p0 + p1) * g_w;
        if (lane == 0) {
            unsigned* cnt = (unsigned*)(ws + WS_CTL) + CW_CNT + l * NE * 64; int* list = (int*)(ws + WS_LIST); float* wl = (float*)(ws + WS_LIST + 4 * MiB);
            const int ge0 = gs * 8 + e0, ge1 = gs * 8 + e1;
            const unsigned q0 = atomicAdd(cnt + ge0 * 64, 1u); list[(size_t)ge0 * T + q0] = row * 2; wl[(size_t)ge0 * T + q0] = w0;
            const unsigned q1 = atomicAdd(cnt + ge1 * 64, 1u); list[(size_t)ge1 * T + q1] = row * 2 + 1; wl[(size_t)ge1 * T + q1] = w1;
        }
    }
}
template <int MODE> __global__ void __launch_bounds__(512) k_norm(Params p) {
    const int wave = threadIdx.x >> 6, lane = threadIdx.x & 63, gw = blockIdx.x * 8 + wave, ngw = gridDim.x * 8;
    for (int row = gw; row < T; row += ngw) norm_row<MODE>(p, row, lane);
}

__device__ __forceinline__ void scan_item(const Params& p, int item, int lane) {
    const int b = item >> 6, g = item & 63;
    const float* L16 = (const float*)(p.ws + WS_CONST) + (g * SP + lane) * 2; const float ar = L16[0], ai = L16[1];
    const float* SL = (const float*)(p.ws + WS_R3) + ((size_t)g * NCR + (size_t)b * 256) * 128;
    bf16* UX = (bf16*)(p.ws + WS_R2) + ((size_t)g * NCR + (size_t)b * 256) * UXP + 256;
    float sr = 0.f, si = 0.f;
    for (int c = 0; c < 256; ++c) {
        UX[(size_t)c * UXP + lane] = (bf16)f2bf(sr); UX[(size_t)c * UXP + 64 + lane] = (bf16)f2bf(si);
        const float lr = SL[(size_t)c * 128 + lane], li = SL[(size_t)c * 128 + 64 + lane];
        const float nr = ar * sr - ai * si + lr, ni = ar * si + ai * sr + li; sr = nr; si = ni;
    }
}
__global__ void __launch_bounds__(512) k_scan(Params p) {
    const int wave = threadIdx.x >> 6, lane = threadIdx.x & 63, gw = blockIdx.x * 8 + wave, ngw = gridDim.x * 8;
    for (int it = gw; it < NB * SG; it += ngw) scan_item(p, it, lane);
}

__global__ void __launch_bounds__(256) k_naive_attn(Params p) {
    __shared__ float ssq[64][4];
    const int blk = blockIdx.x, qc = blk & 63, bh = blk >> 6, b = bh >> 3, head = bh & 7;
    const int q = threadIdx.x >> 2, eg = threadIdx.x & 3;
    const bf16* Q = (const bf16*)(p.ws + WS_R2); const bf16* KIMG = Q + (size_t)T * D; const bf16* VIMG = (const bf16*)(p.ws + WS_R3);
    const float* cst = (const float*)(p.ws + WS_CONST + 65536); const float lam = cst[0], oml = cst[1];
    const size_t t = (size_t)b * SEQ + qc * 64 + q;
    float q0[64], q1[64];
    for (int d = 0; d < 64; d += 8) { unpack8(*(const u32x4*)(Q + t * D + head * 128 + d), q0 + d); unpack8(*(const u32x4*)(Q + t * D + head * 128 + 64 + d), q1 + d); }
    float a0[32], a1[32]; for (int i = 0; i < 32; ++i) { a0[i] = 0.f; a1[i] = 0.f; }
    float m0 = -1e30f, m1 = -1e30f, l0 = 0.f, l1 = 0.f;
    const int nk = (qc + 1) * 64;
    for (int key = 0; key < nk; ++key) {
        const bf16* kb = KIMG + ((size_t)bh * 64 + (key >> 6)) * 8192 + (key & 63) * 8;
        float s0 = 0.f, s1 = 0.f;
        for (int ch = 0; ch < 8; ++ch) { float kv[8]; unpack8(*(const u32x4*)(kb + ch * 512), kv); for (int i = 0; i < 8; ++i) s0 += q0[ch * 8 + i] * kv[i];
            unpack8(*(const u32x4*)(kb + (8 + ch) * 512), kv); for (int i = 0; i < 8; ++i) s1 += q1[ch * 8 + i] * kv[i]; }
        const bf16* vb = VIMG + ((size_t)bh * 64 + (key >> 6)) * 8192 + eg * 2048 + ((key & 63) >> 4) * 512 + (key & 15) * 32;
        float vv[32]; for (int i = 0; i < 32; i += 8) unpack8(*(const u32x4*)(vb + i), vv + i);
        if (s0 > m0) { const float f = exp2f(m0 - s0); l0 *= f; for (int i = 0; i < 32; ++i) a0[i] *= f; m0 = s0; }
        if (s1 > m1) { const float f = exp2f(m1 - s1); l1 *= f; for (int i = 0; i < 32; ++i) a1[i] *= f; m1 = s1; }
        const float p0 = exp2f(s0 - m0), p1 = exp2f(s1 - m1); l0 += p0; l1 += p1;
        for (int i = 0; i < 32; ++i) { a0[i] += p0 * vv[i]; a1[i] += p1 * vv[i]; }
    }
    float o[32], ss = 0.f; const float r0 = 1.f / l0, r1 = lam / l1;
    for (int i = 0; i < 32; ++i) { o[i] = a0[i] * r0 - a1[i] * r1; ss += o[i] * o[i]; }
    ssq[q][eg] = ss; __syncthreads();
    const float tot = ssq[q][0] + ssq[q][1] + ssq[q][2] + ssq[q][3]; const float rs = 1.f / sqrtf(tot * (1.f / 128.f) + EPS) * oml;
    const float* sg = p.in[19];
    float ov[32]; for (int i = 0; i < 32; ++i) ov[i] = o[i] * rs * sg[eg * 32 + i];
    bf16* O = (bf16*)(p.ws + WS_R2) + t * D + head * 128 + eg * 32;
    __syncthreads();
    for (int i = 0; i < 32; i += 8) *(u32x4*)(O + i) = pack8(ov + i);
}

template <class S, class E> static void launch_gemm(S s, E e, int K, int nunits, hipStream_t st) { hipLaunchKernelGGL((k_naive_gemm<S, E>), dim3(nunits * 16), dim3(256), 0, st, s, e, K); }

extern "C" void kernel_launch(void* const* d_in, const int* in_sizes, int n_in, void* d_out, int out_size, void* d_ws, size_t ws_size, hipStream_t stream) {
    if (n_in != 28 || out_size != T * D || ws_size < WS_END) { fprintf(stderr, "kernel_launch: unexpected shapes n_in %d out %d ws %zu\n", n_in, out_size, ws_size); return; }
    Params p{}; for (int i = 0; i < 28; ++i) p.in[i] = (const float*)d_in[i]; p.out = (float*)d_out; p.ws = (unsigned char*)d_ws;
    unsigned char* ws = p.ws;
    hipMemsetAsync(ws + WS_CTL, 0, CTL_ZERO_BYTES, stream);
    bf16 *H = (bf16*)(ws + WS_R1), *G = (bf16*)(ws + WS_R1), *UX = (bf16*)(ws + WS_R2), *Qb = (bf16*)(ws + WS_R2), *KIMG = Qb + (size_t)T * D, *CBUF = (bf16*)(ws + WS_R2);
    bf16 *VIMG = (bf16*)(ws + WS_R3), *HID = (bf16*)(ws + WS_R3); float* SLOC = (float*)(ws + WS_R3);
    const unsigned* cnt0 = (const unsigned*)(ws + WS_CTL) + CW_CNT; const int* list = (const int*)(ws + WS_LIST); const float* wl = (const float*)(ws + WS_LIST + 4 * MiB);
    hipLaunchKernelGGL(k_ssm_const, dim3(SG), dim3(512), 0, stream, p);
    hipLaunchKernelGGL(k_misc_const, dim3(SEQ * 32 / 256), dim3(256), 0, stream, p);
    hipLaunchKernelGGL(k_conv, dim3(512), dim3(512), 0, stream, p);
    hipLaunchKernelGGL(k_norm<0>, dim3(1024), dim3(512), 0, stream, p);
    { SchedDense s{}; s.A = H; s.Bt = (const bf16*)(ws + WS_WIN); s.nN = 4; s.K = D; s.amode = 0; launch_gemm(s, EpiWin{UX}, D, 128 * 4, stream); }
    { SchedSsm<1> s{}; s.UX = UX; s.Bt = (const bf16*)(ws + WS_MG); s.K = 256; s.brows = 128; launch_gemm(s, EpiSsmA{SLOC}, 256, SG * 8, stream); }
    hipLaunchKernelGGL(k_scan, dim3(64), dim3(512), 0, stream, p);
    { SchedSsm<2> s{}; s.UX = UX; s.Bt = (const bf16*)(ws + WS_TE); s.K = 384; s.brows = 256; launch_gemm(s, EpiSsmC{G}, 384, SG * 8, stream); }
    { SchedDense s{}; s.A = G; s.Bt = (const bf16*)(ws + WS_WGLU); s.nN = 8; s.K = D; s.amode = 1; launch_gemm(s, EpiGlu{p.in[0], p.out}, D, 128 * 8, stream); }
    for (int l = 0; l < 2; ++l) {
        if (l == 1) {
            hipLaunchKernelGGL(k_norm<2>, dim3(1024), dim3(512), 0, stream, p);
            { SchedDense s{}; s.A = H; s.Bt = (const bf16*)(ws + WS_WQKV); s.nN = 12; s.K = D; s.amode = 0;
              launch_gemm(s, EpiQkv{Qb, KIMG, VIMG, (const float*)(ws + WS_ROPE), (const float*)(ws + WS_ROPE) + SEQ * 32}, D, 128 * 12, stream); }
            hipLaunchKernelGGL(k_naive_attn, dim3(NB * NH * 64), dim3(256), 0, stream, p);
            { SchedDense s{}; s.A = Qb; s.Bt = (const bf16*)(ws + WS_WO); s.nN = 4; s.K = D; s.amode = 0; launch_gemm(s, EpiWo{p.out}, D, 128 * 4, stream); }
        }
        if (l == 0) hipLaunchKernelGGL(k_norm<1>, dim3(1024), dim3(512), 0, stream, p); else hipLaunchKernelGGL(k_norm<3>, dim3(1024), dim3(512), 0, stream, p);
        const int maxtiles = 2 * T / 256 + NE;
        { SchedMoe<1> s{}; s.A = H; s.Bt = (const bf16*)(ws + WS_WGU) + (size_t)l * NE * 512 * D; s.cnt = cnt0 + l * NE * 64; s.list = list; launch_gemm(s, EpiMoe1{HID, wl}, D, maxtiles * 2, stream); }
        { SchedMoe<2> s{}; s.A = HID; s.Bt = (const bf16*)(ws + WS_WD) + (size_t)l * NE * D * FE; s.cnt = cnt0 + l * NE * 64; s.list = list; launch_gemm(s, EpiMoe2{CBUF, list}, FE, maxtiles * 4, stream); }
    }
    hipLaunchKernelGGL(k_norm<4>, dim3(1024), dim3(512), 0, stream, p);
}
```

```cpp
#include <hip/hip_runtime.h>
#include <cstdio>
#include <cstdint>
#include <cmath>

#define LAS __attribute__((address_space(3)))
typedef unsigned short bf16;
typedef float f32x4 __attribute__((ext_vector_type(4)));
typedef unsigned u32x4 __attribute__((ext_vector_type(4)));
typedef short bf16x8 __attribute__((ext_vector_type(8)));

constexpr int NB = 8, SEQ = 4096, T = NB * SEQ, D = 1024;
constexpr int SG = 64, SP = 64, SH = 16, CS = 16, NCR = T / CS, UXP = 384;
constexpr int NH = 8, HD = 64, VD = 128;
constexpr int NE = 32, FE = 256;
constexpr float EPS = 1e-6f;
constexpr float LOG2E = 1.4426950408889634f;
constexpr float QSCALE = 0.125f * LOG2E;

constexpr size_t MiB = 1u << 20;
constexpr size_t WS_CTL = 0, CTL_ZERO_BYTES = 1 * MiB;
constexpr size_t WS_CONST = 1 * MiB;
constexpr size_t WS_ROPE = 2 * MiB;
constexpr size_t WS_WIN = 4 * MiB, WS_WGLU = 6 * MiB, WS_WQKV = 10 * MiB, WS_WO = 16 * MiB;
constexpr size_t WS_MG = 18 * MiB;
constexpr size_t WS_TE = 22 * MiB;
constexpr size_t WS_WGU = 34 * MiB;
constexpr size_t WS_WD = 98 * MiB;
constexpr size_t WS_LIST = 130 * MiB;
constexpr size_t WS_R1 = 138 * MiB;
constexpr size_t WS_R2 = 202 * MiB;
constexpr size_t WS_R3 = 330 * MiB;
constexpr size_t WS_END = 394 * MiB;
constexpr int CW_BAR = 4096;
constexpr int CW_CNT = 16384;

constexpr int RING_BYTES = 131072;
constexpr int TAB_OFF = RING_BYTES;
constexpr int MISC_OFF = RING_BYTES + 1024;
constexpr int LDS_BYTES = 147456;

struct Params { const float* in[28]; float* out; unsigned char* ws; };

__device__ __forceinline__ unsigned f2bf(float f) { unsigned u = __builtin_bit_cast(unsigned, f); return (u + 0x7fffu + ((u >> 16) & 1u)) >> 16; }
__device__ __forceinline__ float bf2f(unsigned b) { return __builtin_bit_cast(float, b << 16); }
__device__ __forceinline__ unsigned pk2(float lo, float hi) { return f2bf(lo) | (f2bf(hi) << 16); }
__device__ __forceinline__ u32x4 pack8(const float* v) { u32x4 w; w.x = pk2(v[0], v[1]); w.y = pk2(v[2], v[3]); w.z = pk2(v[4], v[5]); w.w = pk2(v[6], v[7]); return w; }
__device__ __forceinline__ void unpack8(u32x4 w, float* v) { v[0] = bf2f(w.x & 0xffffu); v[1] = bf2f(w.x >> 16); v[2] = bf2f(w.y & 0xffffu); v[3] = bf2f(w.y >> 16);
    v[4] = bf2f(w.z & 0xffffu); v[5] = bf2f(w.z >> 16); v[6] = bf2f(w.w & 0xffffu); v[7] = bf2f(w.w >> 16); }
__device__ __forceinline__ float wave_sum(float v) {
#pragma unroll
    for (int o = 1; o < 64; o <<= 1) v += __shfl_xor(v, o);
    return v;
}
__device__ __forceinline__ float gelu_tanh(float x) { const float u = 0.7978845608028654f * (x + 0.044715f * x * x * x); const float e = __expf(2.f * u); const float th = 1.f - 2.f / (e + 1.f); return 0.5f * x * (1.f + th); }
__device__ __forceinline__ float sigmoidf_(float x) { return 1.f / (1.f + __expf(-x)); }

struct GUnit { int pm, pn, e, aux, cnt, pad; };
__device__ __forceinline__ int xcd_remap(int L, int nwg) { const int q = nwg >> 3, r = nwg & 7, xcd = L & 7, off = L >> 3; return (xcd < r ? xcd * (q + 1) : r * (q + 1) + (xcd - r) * q) + off; }

struct SchedDense {
    static constexpr bool GATHER = false;
    const bf16* A; const bf16* Bt; int nN, K, amode, pad;
    __device__ __forceinline__ bool next(int i, int G, int c, GUnit& u, const LAS int*) const {
        const int nM = T / 256, nwg = nM * nN; const long L = (long)i * G + c; if (L >= nwg) return false;
        const int wgid = xcd_remap((int)L, nwg);
        const int nig = 8 * nN, gid = wgid / nig, fm = gid * 8, gsz = (nM - fm) < 8 ? (nM - fm) : 8;
        u.pm = fm + ((wgid % nig) % gsz); u.pn = (wgid % nig) / gsz; u.e = 0; u.aux = 0; u.cnt = 256; u.pad = 0; return true; }
    __device__ __forceinline__ const char* abase(const GUnit& u) const { return (const char*)(amode == 0 ? A + (size_t)u.pm * 256 * K : A + (size_t)u.pm * 256 * 16); }
    __device__ __forceinline__ unsigned avoff(const GUnit&, int Rr, int C) const { return amode == 0 ? (unsigned)(Rr * K + C) * 2u : (unsigned)((C >> 4) * (T * 16) + Rr * 16 + (C & 15)) * 2u; }
    __device__ __forceinline__ size_t kstepA() const { return amode == 0 ? (size_t)128 : (size_t)4 * T * 16 * 2; }
    __device__ __forceinline__ const char* bbase(const GUnit& u) const { return (const char*)(Bt + (size_t)u.pn * 256 * K); }
    __device__ __forceinline__ size_t hstepB() const { return (size_t)128 * K * 2; }
};
struct SchedSsm {
    static constexpr bool GATHER = false;
    const bf16* UX; const bf16* Bt; int K, brows;
    __device__ __forceinline__ bool next(int i, int G, int c, GUnit& u, const LAS int*) const {
        const int nwg = SG * (NCR / 256); const long L = (long)i * G + c; if (L >= nwg) return false;
        const int wgid = xcd_remap((int)L, nwg); u.e = wgid >> 3; u.pm = wgid & 7; u.pn = 0; u.aux = 0; u.cnt = 256; u.pad = 0; return true; }
    __device__ __forceinline__ const char* abase(const GUnit& u) const { return (const char*)(UX + ((size_t)u.e * NCR + (size_t)u.pm * 256) * UXP); }
    __device__ __forceinline__ unsigned avoff(const GUnit&, int Rr, int C) const { return (unsigned)(Rr * UXP + C) * 2u; }
    __device__ __forceinline__ size_t kstepA() const { return 128; }
    __device__ __forceinline__ const char* bbase(const GUnit& u) const { return (const char*)(Bt + (size_t)u.e * brows * K); }
    __device__ __forceinline__ size_t hstepB() const { return brows == 256 ? (size_t)128 * K * 2 : 0; }
};
template <int PHASE> struct SchedMoe {
    const bf16* A; const bf16* Bt; const int* list; long pad;
    static constexpr bool GATHER = (PHASE == 1);
    static constexpr int NPN = PHASE == 1 ? 2 : 4, KK = PHASE == 1 ? 1024 : 256, BROWS = PHASE == 1 ? 512 : 1024;
    int K;  int pad2;
    __device__ __forceinline__ bool next(int i, int G, int c, GUnit& u, const LAS int* tab) const {
        const int nwg = tab[32] * NPN; const long L = (long)i * G + c; if (L >= nwg) return false;
        const int wgid = xcd_remap((int)L, nwg); const int j = wgid / NPN; u.pn = wgid % NPN;
        int e = 0;
#pragma unroll 1
        for (int k = 1; k < NE; ++k) e = (j >= tab[k]) ? k : e;
        u.e = e; u.pm = j - tab[e]; u.aux = j * 256; u.cnt = tab[64 + e]; u.pad = 0; return true; }
    __device__ __forceinline__ const char* abase(const GUnit& u) const { return (const char*)(PHASE == 1 ? A : A + (size_t)u.aux * FE); }
    __device__ __forceinline__ unsigned avoff(const GUnit& u, int Rr, int C) const {
        if (PHASE == 1) { const int ri = u.pm * 256 + Rr; const int tok = ri < u.cnt ? (list[(size_t)u.e * T + ri] >> 1) : 0; return (unsigned)(tok * D + C) * 2u; }
        return (unsigned)(Rr * FE + C) * 2u; }
    __device__ __forceinline__ size_t kstepA() const { return 128; }
    __device__ __forceinline__ const char* bbase(const GUnit& u) const { return (const char*)(Bt + ((size_t)u.e * BROWS + (size_t)u.pn * 256) * KK); }
    __device__ __forceinline__ size_t hstepB() const { return (size_t)128 * KK * 2; }
};

struct EpiWin { bf16* UX;
    __device__ __forceinline__ void operator()(const GUnit& u, int r, int wc, int fq, const float (&v0)[8], const float (&v1)[8]) const {
        const int t = u.pm * 256 + r, n = t >> 4, s = t & 15;
#pragma unroll
        for (int hb = 0; hb < 2; ++hb) { const int c = u.pn * 256 + hb * 128 + wc * 32 + fq * 8, g = c >> 4, hh = c & 15;
            *(u32x4*)(UX + ((size_t)g * NCR + n) * UXP + s * 16 + hh) = pack8(hb ? v1 : v0); }
    } };
struct EpiSsmA { float* SLOC;
    __device__ __forceinline__ void operator()(const GUnit& u, int r, int wc, int fq, const float (&v0)[8], const float (&v1)[8]) const {
        float* o = SLOC + ((size_t)u.e * NCR + (size_t)u.pm * 256 + r) * 128 + wc * 32 + fq * 8;
        *(f32x4*)o = (f32x4){v0[0], v0[1], v0[2], v0[3]}; *(f32x4*)(o + 4) = (f32x4){v0[4], v0[5], v0[6], v0[7]};
    } };
struct EpiSsmC { bf16* G;
    __device__ __forceinline__ void operator()(const GUnit& u, int r, int wc, int fq, const float (&v0)[8], const float (&v1)[8]) const {
        const int n = u.pm * 256 + r;
#pragma unroll
        for (int hb = 0; hb < 2; ++hb) { const int j = hb * 128 + wc * 32 + fq * 8, tt = j >> 4, ho = j & 15; const size_t tok = (size_t)n * 16 + tt;
            float g[8];
#pragma unroll
            for (int i = 0; i < 8; ++i) g[i] = gelu_tanh(hb ? v1[i] : v0[i]);
            *(u32x4*)(G + ((size_t)u.e * T + tok) * 16 + ho) = pack8(g); }
    } };
struct EpiGlu { const float* xin; float* X;
    __device__ __forceinline__ void operator()(const GUnit& u, int r, int wc, int fq, const float (&v0)[8], const float (&v1)[8]) const {
        const size_t o = ((size_t)u.pm * 256 + r) * D + u.pn * 128 + wc * 32 + fq * 8;
        const f32x4 a = *(const f32x4*)(xin + o), b = *(const f32x4*)(xin + o + 4);
        float m[8];
#pragma unroll
        for (int i = 0; i < 8; ++i) m[i] = v0[i] * sigmoidf_(v1[i]);
        *(f32x4*)(X + o) = (f32x4){a.x + m[0], a.y + m[1], a.z + m[2], a.w + m[3]}; *(f32x4*)(X + o + 4) = (f32x4){b.x + m[4], b.y + m[5], b.z + m[6], b.w + m[7]};
    } };
struct EpiMoe1 { bf16* HID; const float* wl;
    __device__ __forceinline__ void operator()(const GUnit& u, int r, int wc, int fq, const float (&v0)[8], const float (&v1)[8]) const {
        const int ri = u.pm * 256 + r; const float w = ri < u.cnt ? wl[(size_t)u.e * T + ri] : 0.f;
        float h[8];
#pragma unroll
        for (int i = 0; i < 8; ++i) h[i] = v0[i] * sigmoidf_(v0[i]) * v1[i] * w;
        *(u32x4*)(HID + ((size_t)u.aux + r) * FE + u.pn * 128 + wc * 32 + fq * 8) = pack8(h);
    } };
struct EpiMoe2 { bf16* CBUF; const int* list;
    __device__ __forceinline__ void operator()(const GUnit& u, int r, int wc, int fq, const float (&v0)[8], const float (&v1)[8]) const {
        const int ri = u.pm * 256 + r; if (ri >= u.cnt) return;
        const int ent = list[(size_t)u.e * T + ri]; const size_t tok = ent >> 1, slot = ent & 1;
        bf16* o = CBUF + (slot * T + tok) * D + u.pn * 256 + wc * 32 + fq * 8;
        *(u32x4*)o = pack8(v0); *(u32x4*)(o + 128) = pack8(v1);
    } };
struct EpiQkv { bf16* Q; bf16* KIMG; bf16* VIMG; const float* ropec; const float* ropes;
    __device__ __forceinline__ void operator()(const GUnit& u, int r, int wc, int fq, const float (&v0)[8], const float (&v1)[8]) const {
        const int t = u.pm * 256 + r, pos = t & (SEQ - 1), b = t >> 12;
        if (u.pn < 8) {
            const f32x4 c0 = *(const f32x4*)(ropec + pos * 32 + fq * 8), c1 = *(const f32x4*)(ropec + pos * 32 + fq * 8 + 4);
            const f32x4 s0 = *(const f32x4*)(ropes + pos * 32 + fq * 8), s1 = *(const f32x4*)(ropes + pos * 32 + fq * 8 + 4);
            const float cs[8] = {c0.x, c0.y, c0.z, c0.w, c1.x, c1.y, c1.z, c1.w}, sn[8] = {s0.x, s0.y, s0.z, s0.w, s1.x, s1.y, s1.z, s1.w};
            const float sc = u.pn < 4 ? QSCALE : 1.f;
            float o1[8], o2[8];
#pragma unroll
            for (int i = 0; i < 8; ++i) { o1[i] = (v0[i] * cs[i] - v1[i] * sn[i]) * sc; o2[i] = (v1[i] * cs[i] + v0[i] * sn[i]) * sc; }
            const int head = 2 * (u.pn & 3) + (wc >> 1), c = wc & 1;
            if (u.pn < 4) { bf16* o = Q + (size_t)t * D + head * 128 + c * 64 + fq * 8; *(u32x4*)o = pack8(o1); *(u32x4*)(o + 32) = pack8(o2); }
            else { bf16* o = KIMG + (((size_t)(b * NH + head) * 64 + (pos >> 6)) * 8192) + (size_t)(c * 8 + fq) * 512 + (pos & 63) * 8;
                *(u32x4*)o = pack8(o1); *(u32x4*)(o + 4 * 512) = pack8(o2); }
        } else {
#pragma unroll
            for (int hb = 0; hb < 2; ++hb) { const int head = 2 * (u.pn - 8) + hb;
                bf16* o = VIMG + (((size_t)(b * NH + head) * 64 + (pos >> 6)) * 8192) + wc * 2048 + ((pos & 63) >> 4) * 512 + (pos & 15) * 32 + fq * 8;
                *(u32x4*)o = pack8(hb ? v1 : v0); }
        }
    } };
struct EpiWo { float* X;
    __device__ __forceinline__ void operator()(const GUnit& u, int r, int wc, int fq, const float (&v0)[8], const float (&v1)[8]) const {
        float* o = X + ((size_t)u.pm * 256 + r) * D + u.pn * 256 + wc * 32 + fq * 8;
#pragma unroll
        for (int hb = 0; hb < 2; ++hb) { float* p = o + hb * 128; const float* v = hb ? v1 : v0; f32x4 a = *(f32x4*)p, b = *(f32x4*)(p + 4);
            a.x += v[0]; a.y += v[1]; a.z += v[2]; a.w += v[3]; b.x += v[4]; b.y += v[5]; b.z += v[6]; b.w += v[7]; *(f32x4*)p = a; *(f32x4*)(p + 4) = b; }
    } };

namespace pg {
constexpr int BK = 64, HALF = 128, HTB = HALF * BK * 2;
__device__ __forceinline__ int lds_byte(int r, int c) { const int st = (r >> 4) * 2 + (c >> 5), rr = r & 15, cc = c & 31, ob = rr * 64 + cc * 2; return st * 1024 + (ob ^ (((ob >> 9) & 1) << 5)); }
__device__ __forceinline__ void stage_rc(int b, int& R, int& C) { const int st = b / 1024, sb = b % 1024, swz = sb ^ (((sb >> 9) & 1) << 5); R = (st >> 1) * 16 + swz / 64; C = (st & 1) * 32 + (swz % 64) / 2; }
__device__ __forceinline__ int perm32(int rho) { const int n = rho >> 4, i = rho & 15; return 8 * (i >> 2) + 4 * n + (i & 3); }

template <class Sched, class Epi, bool ALIGN_EPI>
__device__ __forceinline__ void gemm_phase(LAS unsigned char* lds, const Sched& S, const Epi& E, int G, int c, const LAS int* tab) {
    int tid = threadIdx.x; asm volatile("" : "+v"(tid));
    const int wid = __builtin_amdgcn_readfirstlane(tid >> 6), lane = tid & 63, wr = wid >> 2, wc = wid & 3, fr = lane & 15, fq = lane >> 4;
    const int K = S.K, nt = K / BK;
    int R[2], C[2]; unsigned voffB[2];
#pragma unroll
    for (int i = 0; i < 2; ++i) { stage_rc(tid * 16 + i * 8192, R[i], C[i]); const int Rb = (R[i] & ~31) + perm32(R[i] & 31); voffB[i] = (unsigned)(Rb * K + C[i]) * 2u; }
    const size_t kstepA = S.kstepA(), hstepB = S.hstepB();
    const unsigned ldsw = (unsigned)wid * 1024u;
    const int aoff = lds_byte(wr * 64 + fr, fq * 8), boff = lds_byte(wc * 32 + fr, fq * 8);
#define PG_SA(b, h) (((b) * 2 + (h)) * HTB)
#define PG_SB(b, h) ((4 + (b) * 2 + (h)) * HTB)
#define PG_STAGE(bufoff, gbase, voff) do { _Pragma("unroll") for (int _i = 0; _i < 2; ++_i) \
        __builtin_amdgcn_global_load_lds((const unsigned*)((const char*)(gbase) + (voff)[_i]), (LAS unsigned*)(lds + (bufoff) + ldsw + _i * 8192), 16, 0, 0); } while (0)
#define PG_LDA(dst, b, h) do { _Pragma("unroll") for (int m = 0; m < 4; ++m) _Pragma("unroll") for (int k = 0; k < 2; ++k) dst[m][k] = *(const LAS bf16x8*)(lds + PG_SA(b, h) + aoff + m * 2048 + k * 1024); } while (0)
#define PG_LDB(dst, b, h) do { _Pragma("unroll") for (int n = 0; n < 2; ++n) _Pragma("unroll") for (int k = 0; k < 2; ++k) dst[n][k] = *(const LAS bf16x8*)(lds + PG_SB(b, h) + boff + n * 2048 + k * 1024); } while (0)
#define PG_MMA(ai, bj, At, Bt) do { __builtin_amdgcn_s_setprio(1); _Pragma("unroll") for (int m = 0; m < 4; ++m) _Pragma("unroll") for (int n = 0; n < 2; ++n) _Pragma("unroll") for (int k = 0; k < 2; ++k) \
        acc[ai][bj][m][n] = __builtin_amdgcn_mfma_f32_16x16x32_bf16(Bt[n][k], At[m][k], acc[ai][bj][m][n], 0, 0, 0); __builtin_amdgcn_s_setprio(0); } while (0)
#define PG_WAIT_V(n) asm volatile("s_waitcnt vmcnt(" #n ")" ::: "memory")
#define PG_WAIT_L(n) asm volatile("s_waitcnt lgkmcnt(" #n ")" ::: "memory")
#define PG_BAR __builtin_amdgcn_s_barrier()
#define PG_SCHED __builtin_amdgcn_sched_barrier(0)
    GUnit cur, nxt; int ui = 0;
    if (!S.next(0, G, c, cur, tab)) return;
    unsigned voffA[2][2];
#pragma unroll
    for (int h = 0; h < 2; ++h)
#pragma unroll
        for (int i = 0; i < 2; ++i) voffA[h][i] = S.avoff(cur, h * 128 + R[i], C[i]);
    f32x4 acc[2][2][4][2];
#pragma unroll
    for (int a = 0; a < 2; ++a)
#pragma unroll
        for (int b = 0; b < 2; ++b)
#pragma unroll
            for (int m = 0; m < 4; ++m)
#pragma unroll
                for (int n = 0; n < 2; ++n) acc[a][b][m][n] = (f32x4){0.f, 0.f, 0.f, 0.f};
    bf16x8 At[4][2], B0[2][2], B1[2][2];
    const char* cA = S.abase(cur); const char* cB = S.bbase(cur);
    PG_STAGE(PG_SB(0, 0), cB, voffB); PG_STAGE(PG_SB(0, 1), cB + hstepB, voffB); PG_STAGE(PG_SA(0, 0), cA, voffA[0]); PG_STAGE(PG_SA(0, 1), cA, voffA[1]);
    if (wr == 1) PG_BAR;
    PG_WAIT_V(2); PG_BAR;
    PG_STAGE(PG_SB(1, 0), cB + 128, voffB); PG_STAGE(PG_SA(1, 0), cA + kstepA, voffA[0]); PG_STAGE(PG_SB(1, 1), cB + hstepB + 128, voffB);
    PG_WAIT_V(6); PG_BAR;
    for (;;) {
        const bool has_next = S.next(ui + 1, G, c, nxt, tab);
        const char* nA = has_next ? S.abase(nxt) : cA; const char* nB = has_next ? S.bbase(nxt) : cB;
        for (int t = 0; t < nt; t += 2) {
            const bool last = (t == nt - 2);
            const char* a1 = cA + (size_t)(t + 1) * kstepA;
            const char* a2 = last ? nA : cA + (size_t)(t + 2) * kstepA; const char* b2 = last ? nB : cB + (size_t)(t + 2) * 128;
            const char* a3 = a2 + kstepA; const char* b3 = b2 + 128;
            if (Sched::GATHER && last && has_next) {
#pragma unroll
                for (int i = 0; i < 2; ++i) voffA[0][i] = S.avoff(nxt, R[i], C[i]); }
            PG_LDB(B0, 0, 0); PG_LDB(B1, 0, 1); PG_SCHED; PG_LDA(At, 0, 0); PG_STAGE(PG_SA(1, 1), a1, voffA[1]);
            if (Sched::GATHER && last && has_next) {
#pragma unroll
                for (int i = 0; i < 2; ++i) voffA[1][i] = S.avoff(nxt, 128 + R[i], C[i]); }
            PG_WAIT_V(8); PG_WAIT_L(0); PG_BAR; PG_MMA(0, 0, At, B0); PG_MMA(0, 1, At, B1); PG_BAR; PG_SCHED;
            PG_LDA(At, 0, 1); PG_STAGE(PG_SB(0, 0), b2, voffB); PG_STAGE(PG_SB(0, 1), b2 + hstepB, voffB); PG_STAGE(PG_SA(0, 0), a2, voffA[0]);
            PG_WAIT_V(8); PG_WAIT_L(0); PG_BAR; PG_MMA(1, 0, At, B0); PG_MMA(1, 1, At, B1); PG_BAR; PG_SCHED;
            PG_LDB(B0, 1, 0); PG_LDB(B1, 1, 1); PG_SCHED; PG_LDA(At, 1, 0); PG_STAGE(PG_SA(0, 1), a2, voffA[1]);
            PG_WAIT_V(8); PG_WAIT_L(0); PG_BAR; PG_MMA(0, 0, At, B0); PG_MMA(0, 1, At, B1); PG_BAR; PG_SCHED;
            PG_LDA(At, 1, 1); PG_STAGE(PG_SB(1, 0), b3, voffB); PG_STAGE(PG_SB(1, 1), b3 + hstepB, voffB); PG_STAGE(PG_SA(1, 0), a3, voffA[0]);
            PG_WAIT_V(8); PG_WAIT_L(0); PG_BAR; PG_MMA(1, 0, At, B0); PG_MMA(1, 1, At, B1); PG_BAR; PG_SCHED;
        }
        if constexpr (ALIGN_EPI) { if (wr == 0) PG_BAR; }
        int frE = fr, fqE = fq; asm volatile("" : "+v"(frE), "+v"(fqE));
#pragma unroll
        for (int ai = 0; ai < 2; ++ai)
#pragma unroll
            for (int m = 0; m < 4; ++m) {
                const float v0[8] = {acc[ai][0][m][0][0], acc[ai][0][m][0][1], acc[ai][0][m][0][2], acc[ai][0][m][0][3], acc[ai][0][m][1][0], acc[ai][0][m][1][1], acc[ai][0][m][1][2], acc[ai][0][m][1][3]};
                const float v1[8] = {acc[ai][1][m][0][0], acc[ai][1][m][0][1], acc[ai][1][m][0][2], acc[ai][1][m][0][3], acc[ai][1][m][1][0], acc[ai][1][m][1][1], acc[ai][1][m][1][2], acc[ai][1][m][1][3]};
                E(cur, ai * 128 + wr * 64 + m * 16 + frE, wc, fqE, v0, v1);
            }
        if (!has_next) break;
#pragma unroll
        for (int a = 0; a < 2; ++a)
#pragma unroll
            for (int b = 0; b < 2; ++b)
#pragma unroll
                for (int m = 0; m < 4; ++m)
#pragma unroll
                    for (int n = 0; n < 2; ++n) acc[a][b][m][n] = (f32x4){0.f, 0.f, 0.f, 0.f};
        cur = nxt; cA = nA; cB = nB; ++ui;
        if constexpr (ALIGN_EPI) { if (wr == 1) PG_BAR; }
    }
    PG_WAIT_V(0);
    if constexpr (!ALIGN_EPI) { if (wr == 0) PG_BAR; }
    PG_BAR;
#undef PG_SA
#undef PG_SB
#undef PG_STAGE
#undef PG_LDA
#undef PG_LDB
#undef PG_MMA
#undef PG_WAIT_V
#undef PG_WAIT_L
#undef PG_BAR
#undef PG_SCHED
}
}


namespace at {
typedef float f32x16 __attribute__((ext_vector_type(16)));
typedef short s16x4 __attribute__((ext_vector_type(4)));
typedef short v4i16_t __attribute__((ext_vector_type(4)));
typedef float f32x2_t __attribute__((ext_vector_type(2))); typedef __bf16 bf16x2_t __attribute__((ext_vector_type(2)));
constexpr int STG = 32768, WSF_OFF = 65536;
__device__ __forceinline__ int crow(int r, int hi) { return (r & 3) + 8 * (r >> 2) + 4 * hi; }
__device__ __forceinline__ void glds16(const void* gsrc, unsigned lds_dst) { unsigned keep;
    asm volatile("s_mov_b32 %0, m0\n\ts_mov_b32 m0, %2\n\ts_nop 0\n\tglobal_load_lds_dwordx4 %1, off\n\ts_mov_b32 m0, %0" : "=&s"(keep) : "v"(gsrc), "s"(lds_dst) : "memory"); }
__device__ __forceinline__ unsigned cvtpk(float lo, float hi) { f32x2_t v = {lo, hi}; bf16x2_t b = __builtin_convertvector(v, bf16x2_t); return __builtin_bit_cast(unsigned, b); }
__device__ __forceinline__ s16x4 vtr(const LAS unsigned char* p) { return __builtin_bit_cast(s16x4, __builtin_amdgcn_ds_read_tr16_b64_v4i16((LAS v4i16_t*)p)); }
__device__ __forceinline__ float swapmax(float v) { auto rr = __builtin_amdgcn_permlane32_swap(__float_as_uint(v), __float_as_uint(v), false, false); return fmaxf(__uint_as_float(rr[0]), __uint_as_float(rr[1])); }
__device__ __forceinline__ float swapadd(float v) { auto rr = __builtin_amdgcn_permlane32_swap(__float_as_uint(v), __float_as_uint(v), false, false); return __uint_as_float(rr[0]) + __uint_as_float(rr[1]); }
#define AT_WAIT_BAR() asm volatile("s_waitcnt vmcnt(0) lgkmcnt(0)\n\ts_barrier" ::: "memory")
#define AT_LWAIT() asm volatile("s_waitcnt lgkmcnt(0)" ::: "memory")

template <int THR>
__device__ __forceinline__ void attn_unit(const bf16* Q, const bf16* KIMG, const bf16* VIMG, bf16* O, const float* subg, float lam, float oml, int bh, int qb, LAS unsigned char* L, int wid, int lane) {
    const int r32 = lane & 31, hi = lane >> 5, qg = wid >> 1, c = wid & 1, b = bh >> 3, head = bh & 7;
    const size_t qrow = (size_t)b * SEQ + qb * 128 + qg * 32;
    const int NT = 2 * qb + 2, myNT = 2 * qb + 1 + (qg >> 1);
    const unsigned lbase = (unsigned)(size_t)L;
    const char* kt0 = (const char*)(KIMG + (size_t)bh * 64 * 8192) + wid * 1024 + lane * 16;
    const char* vt0 = (const char*)(VIMG + (size_t)bh * 64 * 8192) + wid * 1024 + lane * 16;
#define AT_DMA(t, s) do { const unsigned d_ = (unsigned)__builtin_amdgcn_readfirstlane(lbase + (s) * STG + wid * 1024); const size_t o_ = (size_t)(t) * 16384; \
        glds16(kt0 + o_, d_); glds16(kt0 + o_ + 8192, d_ + 8192); glds16(vt0 + o_, d_ + 16384); glds16(vt0 + o_ + 8192, d_ + 16384 + 8192); } while (0)
    AT_DMA(0, 0);
    bf16x8 qr[4];
#pragma unroll
    for (int d0 = 0; d0 < 4; ++d0) qr[d0] = *(const bf16x8*)(Q + (qrow + r32) * D + head * 128 + c * 64 + d0 * 16 + hi * 8);
    f32x16 o[4];
#pragma unroll
    for (int db = 0; db < 4; ++db)
#pragma unroll
        for (int r = 0; r < 16; ++r) o[db][r] = 0.f;
    float m = -1e30f, l = 0.f;
    LAS float* wsf = (LAS float*)(L + WSF_OFF) + wid * 64;
    const int vlo = ((lane >> 4) & 1) * 32 + (lane & 3) * 8 + (4 * hi + ((lane & 15) >> 2)) * 64;
    for (int t = 0; t < NT; ++t) {
        AT_WAIT_BAR();
        if (t + 1 < NT) AT_DMA(t + 1, (t + 1) & 1);
        if (t < myNT) {
            const LAS unsigned char* Kb = L + (t & 1) * STG; const LAS unsigned char* Vb = Kb + 16384;
            f32x16 p0, p1;
#pragma unroll
            for (int r = 0; r < 16; ++r) { p0[r] = 0.f; p1[r] = 0.f; }
#pragma unroll
            for (int d0 = 0; d0 < 4; ++d0) { const LAS unsigned char* kp = Kb + (c * 8 + 2 * d0 + hi) * 1024 + r32 * 16;
                const bf16x8 k0 = *(const LAS bf16x8*)kp, k1 = *(const LAS bf16x8*)(kp + 512);
                p0 = __builtin_amdgcn_mfma_f32_32x32x16_bf16(k0, qr[d0], p0, 0, 0, 0); p1 = __builtin_amdgcn_mfma_f32_32x32x16_bf16(k1, qr[d0], p1, 0, 0, 0); }
            float rm = fmaxf(p0[0], p1[0]);
#pragma unroll
            for (int r = 1; r < 16; ++r) rm = fmaxf(rm, fmaxf(p0[r], p1[r]));
            rm = swapmax(rm);
            if (__any(rm > m + (float)THR)) {
                const float mn = fmaxf(m, rm); const float alpha = __builtin_amdgcn_exp2f(m - mn); m = mn; l *= alpha;
                if (hi == 0) wsf[r32] = alpha;
                AT_LWAIT();
#pragma unroll
                for (int r = 0; r < 16; ++r) { const float a = wsf[crow(r, hi)];
#pragma unroll
                    for (int db = 0; db < 4; ++db) o[db][r] *= a; }
                AT_LWAIT();
            }
            float sacc = 0.f;
#pragma unroll
            for (int r = 0; r < 16; ++r) { p0[r] = __builtin_amdgcn_exp2f(p0[r] - m); p1[r] = __builtin_amdgcn_exp2f(p1[r] - m); sacc += p0[r] + p1[r]; }
            l += sacc;
            u32x4 pw[4];
#pragma unroll
            for (int i = 0; i < 4; ++i) { pw[0][i] = cvtpk(p0[2 * i], p0[2 * i + 1]); pw[1][i] = cvtpk(p0[8 + 2 * i], p0[8 + 2 * i + 1]); pw[2][i] = cvtpk(p1[2 * i], p1[2 * i + 1]); pw[3][i] = cvtpk(p1[8 + 2 * i], p1[8 + 2 * i + 1]); }
#pragma unroll
            for (int ks = 0; ks < 4; ++ks) { const bf16x8 pa = __builtin_bit_cast(bf16x8, pw[ks]);
#pragma unroll
                for (int db = 0; db < 4; ++db) { const LAS unsigned char* vp = Vb + db * 4096 + ks * 1024 + vlo; const s16x4 a = vtr(vp), bq = vtr(vp + 512);
                    const bf16x8 vf = (bf16x8){a[0], a[1], a[2], a[3], bq[0], bq[1], bq[2], bq[3]};
                    o[db] = __builtin_amdgcn_mfma_f32_32x32x16_bf16(pa, vf, o[db], 0, 0, 0); } }
        }
    }
    const float lt = swapadd(l); const float inv = (c ? lam : 1.f) / lt;
    if (hi == 0) wsf[r32] = inv;
    AT_LWAIT();
    float invr[16];
#pragma unroll
    for (int r = 0; r < 16; ++r) invr[r] = wsf[crow(r, hi)];
    AT_WAIT_BAR();
    LAS float* X = (LAS float*)(L + qg * 16384);
    if (c == 1) {
#pragma unroll
        for (int db = 0; db < 4; ++db)
#pragma unroll
            for (int r = 0; r < 16; ++r) X[(db * 16 + r) * 64 + lane] = o[db][r] * invr[r];
    }
    AT_WAIT_BAR();
    if (c == 0) {
        float ss[16];
#pragma unroll
        for (int r = 0; r < 16; ++r) ss[r] = 0.f;
#pragma unroll
        for (int db = 0; db < 4; ++db)
#pragma unroll
            for (int r = 0; r < 16; ++r) { const float v = o[db][r] * invr[r] - X[(db * 16 + r) * 64 + lane]; o[db][r] = v; ss[r] += v * v; }
#pragma unroll
        for (int r = 0; r < 16; ++r) {
#pragma unroll
            for (int s = 1; s < 32; s <<= 1) ss[r] += __shfl_xor(ss[r], s);
            ss[r] = oml / sqrtf(ss[r] * (1.f / 128.f) + EPS); }
        AT_LWAIT();
        LAS bf16* stg = (LAS bf16*)(L + qg * 16384);
#pragma unroll
        for (int db = 0; db < 4; ++db) { const float g = subg[db * 32 + r32];
#pragma unroll
            for (int r = 0; r < 16; ++r) stg[crow(r, hi) * 128 + db * 32 + r32] = (bf16)f2bf(o[db][r] * ss[r] * g); }
        AT_LWAIT();
#pragma unroll
        for (int i = 0; i < 8; ++i) { const int row = i * 4 + (lane >> 4), ch = lane & 15; const u32x4 v = *(const LAS u32x4*)(stg + row * 128 + ch * 8);
            *(u32x4*)(O + (qrow + row) * D + head * 128 + ch * 8) = v; }
    }
    AT_WAIT_BAR();
#undef AT_DMA
}
#undef AT_WAIT_BAR
#undef AT_LWAIT
}

__device__ __forceinline__ void ssm_const_group(const Params& p, int g, float* sm, int tid) {
    float (*POWr)[17] = (float (*)[17])sm; float (*POWi)[17] = (float (*)[17])(sm + SP * 17);
    float (*BBr)[SH] = (float (*)[SH])(sm + 2 * SP * 17); float (*BBi)[SH] = (float (*)[SH])(sm + 2 * SP * 17 + SP * SH);
    float* KT = sm + 2 * SP * 17 + 2 * SP * SH;
    const float *lam_re = p.in[5], *lam_im = p.in[6], *log_dt = p.in[7], *b_re = p.in[8], *b_im = p.in[9], *c_re = p.in[10], *c_im = p.in[11], *dsk = p.in[12];
    const double dt = exp((double)log_dt[g]);
    for (int i = tid; i < SP * 17; i += 512) { const int pp = i / 17, k = i % 17; const double re = lam_re[g * SP + pp], im = lam_im[g * SP + pp];
        const double mag = exp(re * dt * k), ang = im * dt * k; POWr[pp][k] = (float)(mag * cos(ang)); POWi[pp][k] = (float)(mag * sin(ang)); }
    for (int i = tid; i < SP * SH; i += 512) { const int pp = i / SH, h = i % SH; const double re = lam_re[g * SP + pp], im = lam_im[g * SP + pp];
        const double mag = exp(re * dt), ang = im * dt; const double lr = mag * cos(ang) - 1.0, li = mag * sin(ang);
        const double den = re * re + im * im; const double cr = (lr * re + li * im) / den, ci = (li * re - lr * im) / den;
        const double br = b_re[(g * SP + pp) * SH + h], bi = b_im[(g * SP + pp) * SH + h];
        BBr[pp][h] = (float)(cr * br - ci * bi); BBi[pp][h] = (float)(cr * bi + ci * br); }
    __syncthreads();
    for (int i = tid; i < 4096; i += 512) { const int tau = i >> 8, ho = (i >> 4) & 15, hi = i & 15; float s = 0.f;
        for (int pp = 0; pp < SP; ++pp) { const float cr = c_re[(g * SH + ho) * SP + pp], ci = c_im[(g * SH + ho) * SP + pp];
            const float zr = POWr[pp][tau], zi = POWi[pp][tau]; const float czr = cr * zr - ci * zi, czi = cr * zi + ci * zr;
            s += czr * BBr[pp][hi] - czi * BBi[pp][hi]; }
        KT[i] = s; }
    if (tid < SP) { float* L16 = (float*)(p.ws + WS_CONST); L16[(g * SP + tid) * 2] = POWr[tid][16]; L16[(g * SP + tid) * 2 + 1] = POWi[tid][16]; }
    __syncthreads();
    bf16* MG = (bf16*)(p.ws + WS_MG) + (size_t)g * 128 * 256;
    for (int i = tid; i < 128 * 256; i += 512) { const int j = i >> 8, k = i & 255, ri = j >> 6, pp = j & 63, s = k >> 4, h = k & 15;
        const float zr = POWr[pp][15 - s], zi = POWi[pp][15 - s]; const float vr = zr * BBr[pp][h] - zi * BBi[pp][h], vi = zr * BBi[pp][h] + zi * BBr[pp][h];
        MG[i] = (bf16)f2bf(ri ? vi : vr); }
    bf16* TE = (bf16*)(p.ws + WS_TE) + (size_t)g * 256 * 384;
    for (int i = tid; i < 256 * 384; i += 512) { const int j = i / 384, k = i % 384, tt = j >> 4, ho = j & 15; float v;
        if (k < 256) { const int s = k >> 4, hi = k & 15; v = s <= tt ? KT[((tt - s) << 8) + (ho << 4) + hi] : 0.f; if (s == tt && hi == ho) v += dsk[g * SH + ho]; }
        else { const int kk = k - 256, ri = kk >> 6, pp = kk & 63; const float cr = c_re[(g * SH + ho) * SP + pp], ci = c_im[(g * SH + ho) * SP + pp];
            const float zr = POWr[pp][tt + 1], zi = POWi[pp][tt + 1]; v = ri ? -(cr * zi + ci * zr) : (cr * zr - ci * zi); }
        TE[i] = (bf16)f2bf(v); }
    __syncthreads();
}
__device__ __forceinline__ void misc_const(const Params& p, int i) {
    float* rc = (float*)(p.ws + WS_ROPE); float* rs = rc + SEQ * 32;
    if (i < SEQ * 32) { const int pos = i >> 5, f = i & 31; const float inv = (float)pow(10000.0, -(double)f / 32.0); const float ang = (float)pos * inv;
        rc[i] = (float)cos((double)ang); rs[i] = (float)sin((double)ang); }
    if (i == SEQ * 32) { double s1 = 0, s2 = 0; for (int d = 0; d < HD; ++d) { s1 += (double)p.in[15][d] * p.in[16][d]; s2 += (double)p.in[17][d] * p.in[18][d]; }
        const double lam_init = 0.8 - 0.6 * exp(-0.3 * 1.0); float* c = (float*)(p.ws + WS_CONST + 65536); c[0] = (float)(exp(s1) - exp(s2) + lam_init); c[1] = (float)(1.0 - lam_init); }
}

__device__ __forceinline__ void transpose_item(const float* W, int ldw, int scol0, bf16* WT, int K, int drow0, int k0, float* scr, int lane) {
#pragma unroll 8
    for (int i = 0; i < 32; ++i) { const int kk = 2 * i + (lane >> 5); scr[kk * 33 + (lane & 31)] = W[(size_t)(k0 + kk) * ldw + scol0 + (lane & 31)]; }
    asm volatile("s_waitcnt lgkmcnt(0)" ::: "memory");
    const int c = lane & 7;
#pragma unroll
    for (int j = 0; j < 4; ++j) { const int n = (lane >> 3) + 8 * j; const float* s = scr + (8 * c) * 33 + n;
        u32x4 o; o.x = pk2(s[0 * 33], s[1 * 33]); o.y = pk2(s[2 * 33], s[3 * 33]); o.z = pk2(s[4 * 33], s[5 * 33]); o.w = pk2(s[6 * 33], s[7 * 33]);
        *(u32x4*)(WT + (size_t)(drow0 + n) * K + k0 + 8 * c) = o; }
    asm volatile("s_waitcnt lgkmcnt(0)" ::: "memory");
}
constexpr int CI_WIN = 16 * 32, CI_GLU = 16 * 64, CI_QKV = 16 * 96, CI_WO = 16 * 32, CI_GU = 64 * 16 * 16, CI_WD = 64 * 4 * 32;
constexpr int CI_TOTAL = CI_WIN + CI_GLU + CI_QKV + CI_WO + CI_GU + CI_WD;
__device__ __forceinline__ void conv_item(const Params& p, int it, float* scr, int lane) {
    unsigned char* ws = p.ws;
    if (it < CI_WIN) { const int kb = it / 32, nb = it % 32; transpose_item(p.in[4], D, nb * 32, (bf16*)(ws + WS_WIN), D, nb * 32, kb * 64, scr, lane); return; } it -= CI_WIN;
    if (it < CI_GLU) { const int kb = it / 64, nb = it % 64; const int pn = nb >> 3, bj = (nb >> 2) & 1, i0 = (nb & 3) * 32;
        transpose_item(p.in[13], 2 * D, bj * D + pn * 128 + i0, (bf16*)(ws + WS_WGLU), D, nb * 32, kb * 64, scr, lane); return; } it -= CI_GLU;
    if (it < CI_QKV) { const int kb = it / 96, nb = it % 96; int sc = nb * 32; if (nb < 64) { const int pn = nb >> 3, bj = (nb >> 2) & 1, wc = nb & 3; sc = pn * 256 + wc * 64 + bj * 32; }
        transpose_item(p.in[14], 3 * D, sc, (bf16*)(ws + WS_WQKV), D, nb * 32, kb * 64, scr, lane); return; } it -= CI_QKV;
    if (it < CI_WO) { const int kb = it / 32, nb = it % 32; transpose_item(p.in[20], D, nb * 32, (bf16*)(ws + WS_WO), D, nb * 32, kb * 64, scr, lane); return; } it -= CI_WO;
    if (it < CI_GU) { const int le = it >> 8, r = it & 255, kb = r >> 4, nb = r & 15; const int pn = nb >> 3, bj = (nb >> 2) & 1, i0 = (nb & 3) * 32;
        const float* src = (bj ? p.in[26] : p.in[25]) + (size_t)le * D * FE;
        transpose_item(src, FE, pn * 128 + i0, (bf16*)(ws + WS_WGU) + (size_t)le * 512 * D, D, nb * 32, kb * 64, scr, lane); return; } it -= CI_GU;
    { const int le = it >> 7, r = it & 127, kb = r >> 5, nb = r & 31;
        transpose_item(p.in[27] + (size_t)le * FE * D, D, nb * 32, (bf16*)(ws + WS_WD) + (size_t)le * D * FE, FE, nb * 32, kb * 64, scr, lane); }
}

template <int MODE>
__device__ __forceinline__ void norm_row(const Params& p, int row, int lane) {
    unsigned char* ws = p.ws; constexpr int l = (MODE == 3) ? 1 : 0;
    const float* src = (MODE == 0) ? p.in[0] : p.out; const float* gain = MODE == 0 ? p.in[1] : MODE == 2 ? p.in[1] + D : MODE == 4 ? p.in[3] : p.in[2] + l * D;
    const f32x4* xr = (const f32x4*)(src + (size_t)row * D) + lane;
    f32x4 v[4]; float s = 0.f;
#pragma unroll
    for (int j = 0; j < 4; ++j) v[j] = xr[64 * j];
    if (MODE == 2 || MODE == 4) {
        const bf16* C0 = (const bf16*)(ws + WS_R2) + (size_t)row * D, *C1 = C0 + (size_t)T * D;
#pragma unroll
        for (int j = 0; j < 4; ++j) { const uint2 a = *((const uint2*)C0 + lane + 64 * j), b = *((const uint2*)C1 + lane + 64 * j);
            v[j].x += bf2f(a.x & 0xffffu) + bf2f(b.x & 0xffffu); v[j].y += bf2f(a.x >> 16) + bf2f(b.x >> 16); v[j].z += bf2f(a.y & 0xffffu) + bf2f(b.y & 0xffffu); v[j].w += bf2f(a.y >> 16) + bf2f(b.y >> 16); }
        if (MODE == 2) {
#pragma unroll
            for (int j = 0; j < 4; ++j) ((f32x4*)(p.out + (size_t)row * D) + lane)[64 * j] = v[j]; }
    }
#pragma unroll
    for (int j = 0; j < 4; ++j) s += (v[j].x * v[j].x + v[j].y * v[j].y) + (v[j].z * v[j].z + v[j].w * v[j].w);
    const float rstd = 1.f / sqrtf(wave_sum(s) * (1.f / D) + EPS);
#pragma unroll
    for (int j = 0; j < 4; ++j) { const f32x4 g = ((const f32x4*)gain + lane)[64 * j]; v[j] = v[j] * rstd * g; }
    if (MODE == 4) {
#pragma unroll
        for (int j = 0; j < 4; ++j) ((f32x4*)(p.out + (size_t)row * D) + lane)[64 * j] = v[j];
        return; }
    uint2* o8 = (uint2*)((bf16*)(ws + WS_R1) + (size_t)row * D) + lane;
#pragma unroll
    for (int j = 0; j < 4; ++j) { uint2 o; o.x = pk2(v[j].x, v[j].y); o.y = pk2(v[j].z, v[j].w); o8[64 * j] = o; }
    if (MODE == 1 || MODE == 3) {
        const float* wrg = p.in[21] + (size_t)l * D * 4; const float* wre = p.in[23] + (size_t)l * D * 32; const float* brg = p.in[22] + l * 4; const float* bre = p.in[24] + l * 32;
        float gl[4] = {0.f, 0.f, 0.f, 0.f};
#pragma unroll
        for (int j = 0; j < 4; ++j) { const float xv[4] = {v[j].x, v[j].y, v[j].z, v[j].w};
#pragma unroll
            for (int i = 0; i < 4; ++i) { const int d = 256 * j + 4 * lane + i; const f32x4 w = *(const f32x4*)(wrg + d * 4); gl[0] += xv[i] * w.x; gl[1] += xv[i] * w.y; gl[2] += xv[i] * w.z; gl[3] += xv[i] * w.w; } }
#pragma unroll
        for (int i = 0; i < 4; ++i) gl[i] = wave_sum(gl[i]);
        int gs = 0; float best = gl[0] + brg[0];
#pragma unroll
        for (int i = 1; i < 4; ++i) { const float c = gl[i] + brg[i]; if (c > best) { best = c; gs = i; } }
        const float gm = fmaxf(fmaxf(gl[0], gl[1]), fmaxf(gl[2], gl[3])); float gsum = 0.f, gsel = 0.f;
#pragma unroll
        for (int i = 0; i < 4; ++i) { const float e = __expf(gl[i] - gm); gsum += e; if (i == gs) gsel = e; }
        const float g_w = gsel / gsum;
        float el[8] = {0.f, 0.f, 0.f, 0.f, 0.f, 0.f, 0.f, 0.f};
#pragma unroll
        for (int j = 0; j < 4; ++j) { const float xv[4] = {v[j].x, v[j].y, v[j].z, v[j].w};
#pragma unroll
            for (int i = 0; i < 4; ++i) { const int d = 256 * j + 4 * lane + i; const f32x4 w0 = *(const f32x4*)(wre + d * 32 + gs * 8), w1 = *(const f32x4*)(wre + d * 32 + gs * 8 + 4);
                el[0] += xv[i] * w0.x; el[1] += xv[i] * w0.y; el[2] += xv[i] * w0.z; el[3] += xv[i] * w0.w; el[4] += xv[i] * w1.x; el[5] += xv[i] * w1.y; el[6] += xv[i] * w1.z; el[7] += xv[i] * w1.w; } }
#pragma unroll
        for (int i = 0; i < 8; ++i) el[i] = wave_sum(el[i]);
        float em = el[0];
#pragma unroll
        for (int i = 1; i < 8; ++i) em = fmaxf(em, el[i]);
        float ep[8], esum = 0.f;
#pragma unroll
        for (int i = 0; i < 8; ++i) { ep[i] = __expf(el[i] - em); esum += ep[i]; }
        int e0 = 0, e1 = 0; float b0 = -1e30f, b1 = -1e30f;
#pragma unroll
        for (int i = 0; i < 8; ++i) { ep[i] /= esum; const float c = ep[i] + bre[gs * 8 + i]; if (c > b0) { b0 = c; e0 = i; } }
#pragma unroll
        for (int i = 0; i < 8; ++i) { const float c = ep[i] + bre[gs * 8 + i]; if (i != e0 && c > b1) { b1 = c; e1 = i; } }
        float p0 = 0.f, p1 = 0.f;
#pragma unroll
        for (int i = 0; i < 8; ++i) { if (i == e0) p0 = ep[i]; if (i == e1) p1 = ep[i]; }
        const float w0 = p0 / (p0 + p1) * g_w, w1 = p1 / (p0 + p1) * g_w;
        if (lane == 0) {
            unsigned* cnt = (unsigned*)(ws + WS_CTL) + CW_CNT + l * NE * 64; int* list = (int*)(ws + WS_LIST); float* wl = (float*)(ws + WS_LIST + 4 * MiB);
            const int ge0 = gs * 8 + e0, ge1 = gs * 8 + e1;
            const unsigned q0 = atomicAdd(cnt + ge0 * 64, 1u); list[(size_t)ge0 * T + q0] = row * 2; wl[(size_t)ge0 * T + q0] = w0;
            const unsigned q1 = atomicAdd(cnt + ge1 * 64, 1u); list[(size_t)ge1 * T + q1] = row * 2 + 1; wl[(size_t)ge1 * T + q1] = w1;
        }
    }
}

__device__ __forceinline__ void scan_block(const Params& p, int item, float* sm, int wave, int lane) {
    const int b = item >> 6, g = item & 63;
    const float* L16 = (const float*)(p.ws + WS_CONST) + (g * SP + lane) * 2; const float ar = L16[0], ai = L16[1];
    const float* SL = (const float*)(p.ws + WS_R3) + ((size_t)g * NCR + (size_t)b * 256 + wave * 32) * 128;
    bf16* UX = (bf16*)(p.ws + WS_R2) + ((size_t)g * NCR + (size_t)b * 256 + wave * 32) * UXP + 256;
    float lr[32], li[32];
#pragma unroll
    for (int c = 0; c < 32; ++c) { lr[c] = SL[(size_t)c * 128 + lane]; li[c] = SL[(size_t)c * 128 + 64 + lane]; }
    float er = 0.f, ei = 0.f;
#pragma unroll
    for (int c = 0; c < 32; ++c) { const float nr = ar * er - ai * ei + lr[c], ni = ar * ei + ai * er + li[c]; er = nr; ei = ni; }
    sm[(wave * 64 + lane) * 2] = er; sm[(wave * 64 + lane) * 2 + 1] = ei;
    float a32r = ar, a32i = ai;
#pragma unroll
    for (int k = 0; k < 5; ++k) { const float nr = a32r * a32r - a32i * a32i, ni = 2.f * a32r * a32i; a32r = nr; a32i = ni; }
    __syncthreads();
    float sr = 0.f, si = 0.f;
    for (int v = 0; v < wave; ++v) { const float pr = sm[(v * 64 + lane) * 2], pi = sm[(v * 64 + lane) * 2 + 1]; const float nr = a32r * sr - a32i * si + pr, ni = a32r * si + a32i * sr + pi; sr = nr; si = ni; }
#pragma unroll
    for (int c = 0; c < 32; ++c) {
        UX[(size_t)c * UXP + lane] = (bf16)f2bf(sr); UX[(size_t)c * UXP + 64 + lane] = (bf16)f2bf(si);
        const float nr = ar * sr - ai * si + lr[c], ni = ar * si + ai * sr + li[c]; sr = nr; si = ni;
    }
    __syncthreads();
}

#define XB_TMO      128
#define XB_XCNT(j)  (256  + 64 * (j))
#define XB_XSUB(j)  (1280 + 64 * (j))
#define XB_XGEN(j)  (2304 + 64 * (j))
#define XB_TOP      3328
#define XB_TOPGEN   3392
#define XCD_BAR_WORDS 3456
#define XB_SPIN_CAP (1u << 18)
__device__ __forceinline__ unsigned xb_ld(unsigned* p)              { return __hip_atomic_load(p, __ATOMIC_RELAXED, __HIP_MEMORY_SCOPE_AGENT); }
__device__ __forceinline__ unsigned xb_add(unsigned* p, unsigned v) { return __hip_atomic_fetch_add(p, v, __ATOMIC_RELAXED, __HIP_MEMORY_SCOPE_AGENT); }
__device__ __forceinline__ unsigned xb_xcc_id() { return (unsigned)__builtin_amdgcn_s_getreg((3 << 11) | 20) & 0xFu; }
#define XB_SPIN(cond, bar) do { unsigned _sp = 0; while (cond) { __builtin_amdgcn_s_sleep(1); \
    if ((++_sp & 255u) == 0u) { if (xb_ld(&(bar)[XB_TMO])) break; if (_sp > XB_SPIN_CAP) { atomicAdd(&(bar)[XB_TMO], 1u); break; } } } } while (0)
struct XcdBarrier { unsigned* bar; unsigned x; volatile LAS unsigned* st; };
__device__ __forceinline__ XcdBarrier xcd_barrier_post(unsigned* bar, volatile LAS unsigned* st) {
    XcdBarrier b; b.bar = bar; b.x = xb_xcc_id(); b.st = st;
    if (threadIdx.x == 0) (void)xb_add(&bar[XB_XCNT(b.x)], 1u);
    return b;
}
__device__ __forceinline__ void xcd_barrier_complete(unsigned* bar, unsigned x, unsigned& nloc, unsigned& nx) {
    const unsigned G = gridDim.x * gridDim.y * gridDim.z;
    unsigned sum, cnt, mine, sp = 0u;
    for (;;) {
        sum = 0u; cnt = 0u; mine = 0u;
#pragma unroll
        for (unsigned j = 0; j < 16; ++j) { const unsigned c = xb_ld(&bar[XB_XCNT(j)]); sum += c; cnt += (c > 0u) ? 1u : 0u; mine = (j == x) ? c : mine; }
        if (sum == G) break;
        __builtin_amdgcn_s_sleep(1);
        if ((++sp & 255u) == 0u) { if (xb_ld(&bar[XB_TMO])) break; if (sp > XB_SPIN_CAP) { atomicAdd(&bar[XB_TMO], 1u); break; } }
    }
    nloc = mine > 0u ? mine : 1u; nx = cnt > 0u ? cnt : 1u;
}
__device__ __forceinline__ void xcd_barrier(const XcdBarrier& b) {
    asm volatile("s_waitcnt vmcnt(0)" ::: "memory");
    __syncthreads();
    if (threadIdx.x == 0) {
        unsigned* bar = b.bar;
        __builtin_amdgcn_s_waitcnt(0);
        unsigned nloc = b.st[0], nx = b.st[1];
        if (nloc == 0u) { xcd_barrier_complete(bar, b.x, nloc, nx); b.st[0] = nloc; b.st[1] = nx; }
        const unsigned old = xb_add(&bar[XB_XSUB(b.x)], 1u);
        const unsigned gen = old / nloc;
        if (old + 1u == (gen + 1u) * nloc) {
            __builtin_amdgcn_fence(__ATOMIC_RELEASE, "agent");
            asm volatile("s_waitcnt vmcnt(0)" ::: "memory");
            const unsigned og = xb_add(&bar[XB_TOP], 1u);
            const unsigned tg = og / nx;
            if (og + 1u == (tg + 1u) * nx) xb_add(&bar[XB_TOPGEN], 1u);
            else XB_SPIN(xb_ld(&bar[XB_TOPGEN]) == tg, bar);
            __builtin_amdgcn_fence(__ATOMIC_ACQUIRE, "agent");
            xb_add(&bar[XB_XGEN(b.x)], 1u);
            asm volatile("s_waitcnt vmcnt(0)" ::: "memory");
        } else {
            XB_SPIN(xb_ld(&bar[XB_XGEN(b.x)]) == gen, bar);
            __builtin_amdgcn_fence(__ATOMIC_ACQUIRE, "agent");
            asm volatile("s_waitcnt vmcnt(0)" ::: "memory");
        }
    }
    __syncthreads();
}

constexpr int NPHASE = 17;
#ifndef ATTN_THR
#define ATTN_THR 0
#endif
struct Args { Params p; int ph_lo, ph_hi, li, pad; };

__device__ __forceinline__ void moe_setup(LAS int* tab, unsigned* cnt, int tid) {
    if (tid < NE) tab[64 + tid] = (int)__hip_atomic_load(cnt + tid * 64, __ATOMIC_RELAXED, __HIP_MEMORY_SCOPE_AGENT);
    __syncthreads();
    if (tid == 0) { int pf = 0; for (int e = 0; e < NE; ++e) { tab[e] = pf; pf += (tab[64 + e] + 255) >> 8; } tab[32] = pf; }
    __syncthreads();
}

__global__ void __launch_bounds__(512, 2) fwd(Args args) {
    extern __shared__ __attribute__((aligned(16))) unsigned char lds[];
    const Params& p = args.p; unsigned char* ws = p.ws;
    LAS unsigned char* L = (LAS unsigned char*)lds;
    const int G = gridDim.x, bid = blockIdx.x, NGW = G * 8;
#define PHASE_IDS() int tid = threadIdx.x; asm volatile("" : "+v"(tid)); const int lane = tid & 63, wave = __builtin_amdgcn_readfirstlane(tid >> 6), gw = bid * 8 + wave; (void)lane; (void)gw
    volatile LAS unsigned* MISC = (volatile LAS unsigned*)(L + MISC_OFF);
    LAS int* tab = (LAS int*)(L + TAB_OFF);
    for (int u = threadIdx.x; u < (LDS_BYTES - TAB_OFF) / 4; u += 512) ((LAS unsigned*)(L + TAB_OFF))[u] = 0u;
    __syncthreads();
    unsigned* ctl = (unsigned*)(ws + WS_CTL);
    const int lo = args.ph_lo, hi = args.ph_hi;
    const bool multi = (hi - lo) > 1;
    XcdBarrier bar; bar.bar = ctl + CW_BAR + args.li * XCD_BAR_WORDS; bar.x = 0; bar.st = nullptr;
    if (multi) bar = xcd_barrier_post(ctl + CW_BAR + args.li * XCD_BAR_WORDS, MISC + 8);
#define IN(k) (lo <= (k) && (k) < hi)
#define SEAM(k) do { if (IN(k) && IN((k) + 1)) xcd_barrier(bar); } while (0)
    bf16 *H = (bf16*)(ws + WS_R1), *Gm = (bf16*)(ws + WS_R1), *UX = (bf16*)(ws + WS_R2), *Qb = (bf16*)(ws + WS_R2), *KIMG = Qb + (size_t)T * D, *CBUF = (bf16*)(ws + WS_R2);
    bf16 *VIMG = (bf16*)(ws + WS_R3), *HID = (bf16*)(ws + WS_R3); float* SLOC = (float*)(ws + WS_R3);
    const int* list = (const int*)(ws + WS_LIST); const float* wl = (const float*)(ws + WS_LIST + 4 * MiB);

    if (IN(0)) { PHASE_IDS();
        if (bid < SG) ssm_const_group(p, bid, (float*)lds, tid);
        for (int i = (G - 1 - bid) * 512 + tid; i <= SEQ * 32; i += G * 512) misc_const(p, i);
        float* scr = (float*)(lds + 40960 + wave * 8448);
        for (int it = gw; it < CI_TOTAL; it += NGW) conv_item(p, it, scr, lane);
        for (int row = gw; row < T; row += NGW) norm_row<0>(p, row, lane);
        __syncthreads();
    }
    SEAM(0);
    if (IN(1)) { SchedDense s{H, (const bf16*)(ws + WS_WIN), 4, D, 0, 0}; EpiWin e{UX}; pg::gemm_phase<SchedDense, EpiWin, true>(L, s, e, G, bid, tab); }
    SEAM(1);
    if (IN(2)) { SchedSsm s{UX, (const bf16*)(ws + WS_MG), 256, 128}; EpiSsmA e{SLOC}; pg::gemm_phase<SchedSsm, EpiSsmA, true>(L, s, e, G, bid, tab); }
    SEAM(2);
    if (IN(3)) { PHASE_IDS(); for (int it = bid; it < NB * SG; it += G) scan_block(p, it, (float*)lds, wave, lane); }
    SEAM(3);
    if (IN(4)) { SchedSsm s{UX, (const bf16*)(ws + WS_TE), 384, 256}; EpiSsmC e{Gm}; pg::gemm_phase<SchedSsm, EpiSsmC, true>(L, s, e, G, bid, tab); }
    SEAM(4);
    if (IN(5)) { SchedDense s{Gm, (const bf16*)(ws + WS_WGLU), 8, D, 1, 0}; EpiGlu e{p.in[0], p.out}; pg::gemm_phase<SchedDense, EpiGlu, true>(L, s, e, G, bid, tab); }
    SEAM(5);
    if (IN(6)) { PHASE_IDS(); for (int row = gw; row < T; row += NGW) norm_row<1>(p, row, lane); }
    SEAM(6);
    if (IN(7)) { PHASE_IDS(); moe_setup(tab, ctl + CW_CNT, tid);
        SchedMoe<1> s{H, (const bf16*)(ws + WS_WGU), list, 0, 1024, 0}; EpiMoe1 e{HID, wl}; pg::gemm_phase<SchedMoe<1>, EpiMoe1, true>(L, s, e, G, bid, tab); }
    SEAM(7);
    if (IN(8)) { PHASE_IDS(); moe_setup(tab, ctl + CW_CNT, tid);
        SchedMoe<2> s{HID, (const bf16*)(ws + WS_WD), list, 0, 256, 0}; EpiMoe2 e{CBUF, list}; pg::gemm_phase<SchedMoe<2>, EpiMoe2, true>(L, s, e, G, bid, tab); }
    SEAM(8);
    if (IN(9)) { PHASE_IDS(); for (int row = gw; row < T; row += NGW) norm_row<2>(p, row, lane); }
    SEAM(9);
    if (IN(10)) { SchedDense s{H, (const bf16*)(ws + WS_WQKV), 12, D, 0, 0}; EpiQkv e{Qb, KIMG, VIMG, (const float*)(ws + WS_ROPE), (const float*)(ws + WS_ROPE) + SEQ * 32};
        pg::gemm_phase<SchedDense, EpiQkv, true>(L, s, e, G, bid, tab); }
    SEAM(10);
    if (IN(11)) { PHASE_IDS(); const float* cst = (const float*)(ws + WS_CONST + 65536); const float lam = cst[0], oml = cst[1];
        const int vcu = (G % 8 == 0) ? (bid % 8) * (G / 8) + bid / 8 : bid;
        for (int pr = vcu; pr < NB * NH * 16; pr += G) { const int bh = pr >> 4, s = pr & 15;
            at::attn_unit<ATTN_THR>(Qb, KIMG, VIMG, Qb, p.in[19], lam, oml, bh, 31 - s, L, wave, lane);
            at::attn_unit<ATTN_THR>(Qb, KIMG, VIMG, Qb, p.in[19], lam, oml, bh, s, L, wave, lane); } }
    SEAM(11);
    if (IN(12)) { SchedDense s{Qb, (const bf16*)(ws + WS_WO), 4, D, 0, 0}; EpiWo e{p.out}; pg::gemm_phase<SchedDense, EpiWo, true>(L, s, e, G, bid, tab); }
    SEAM(12);
    if (IN(13)) { PHASE_IDS(); for (int row = gw; row < T; row += NGW) norm_row<3>(p, row, lane); }
    SEAM(13);
    if (IN(14)) { PHASE_IDS(); moe_setup(tab, ctl + CW_CNT + NE * 64, tid);
        SchedMoe<1> s{H, (const bf16*)(ws + WS_WGU) + (size_t)NE * 512 * D, list, 0, 1024, 0}; EpiMoe1 e{HID, wl}; pg::gemm_phase<SchedMoe<1>, EpiMoe1, true>(L, s, e, G, bid, tab); }
    SEAM(14);
    if (IN(15)) { PHASE_IDS(); moe_setup(tab, ctl + CW_CNT + NE * 64, tid);
        SchedMoe<2> s{HID, (const bf16*)(ws + WS_WD) + (size_t)NE * D * FE, list, 0, 256, 0}; EpiMoe2 e{CBUF, list}; pg::gemm_phase<SchedMoe<2>, EpiMoe2, true>(L, s, e, G, bid, tab); }
    SEAM(15);
    if (IN(16)) { PHASE_IDS(); for (int row = gw; row < T; row += NGW) norm_row<4>(p, row, lane); }
#undef IN
#undef SEAM
#undef PHASE_IDS
}

__global__ void __launch_bounds__(256) k_naive_attn(Params p) {
    __shared__ float ssq[64][4];
    const int blk = blockIdx.x, qc = blk & 63, bh = blk >> 6, b = bh >> 3, head = bh & 7;
    const int q = threadIdx.x >> 2, eg = threadIdx.x & 3;
    const bf16* Q = (const bf16*)(p.ws + WS_R2); const bf16* KIMG = Q + (size_t)T * D; const bf16* VIMG = (const bf16*)(p.ws + WS_R3);
    const float* cst = (const float*)(p.ws + WS_CONST + 65536); const float lam = cst[0], oml = cst[1];
    const size_t t = (size_t)b * SEQ + qc * 64 + q;
    float q0[64], q1[64];
#pragma unroll
    for (int d = 0; d < 64; d += 8) { unpack8(*(const u32x4*)(Q + t * D + head * 128 + d), q0 + d); unpack8(*(const u32x4*)(Q + t * D + head * 128 + 64 + d), q1 + d); }
    float a0[32], a1[32];
#pragma unroll
    for (int i = 0; i < 32; ++i) { a0[i] = 0.f; a1[i] = 0.f; }
    float m0 = -1e30f, m1 = -1e30f, l0 = 0.f, l1 = 0.f;
    const int nk = (qc + 1) * 64;
    for (int key = 0; key < nk; ++key) {
        const bf16* kb = KIMG + ((size_t)bh * 64 + (key >> 6)) * 8192 + (key & 63) * 8;
        float s0 = 0.f, s1 = 0.f;
#pragma unroll
        for (int ch = 0; ch < 8; ++ch) { float kv[8]; unpack8(*(const u32x4*)(kb + ch * 512), kv);
#pragma unroll
            for (int i = 0; i < 8; ++i) s0 += q0[ch * 8 + i] * kv[i];
            unpack8(*(const u32x4*)(kb + (8 + ch) * 512), kv);
#pragma unroll
            for (int i = 0; i < 8; ++i) s1 += q1[ch * 8 + i] * kv[i]; }
        const bf16* vb = VIMG + ((size_t)bh * 64 + (key >> 6)) * 8192 + eg * 2048 + ((key & 63) >> 4) * 512 + (key & 15) * 32;
        float vv[32];
#pragma unroll
        for (int i = 0; i < 32; i += 8) unpack8(*(const u32x4*)(vb + i), vv + i);
        if (s0 > m0) { const float f = exp2f(m0 - s0); l0 *= f;
#pragma unroll
            for (int i = 0; i < 32; ++i) a0[i] *= f;
            m0 = s0; }
        if (s1 > m1) { const float f = exp2f(m1 - s1); l1 *= f;
#pragma unroll
            for (int i = 0; i < 32; ++i) a1[i] *= f;
            m1 = s1; }
        const float p0 = exp2f(s0 - m0), p1 = exp2f(s1 - m1); l0 += p0; l1 += p1;
#pragma unroll
        for (int i = 0; i < 32; ++i) { a0[i] += p0 * vv[i]; a1[i] += p1 * vv[i]; }
    }
    float o[32], ss = 0.f; const float r0 = 1.f / l0, r1 = lam / l1;
#pragma unroll
    for (int i = 0; i < 32; ++i) { o[i] = a0[i] * r0 - a1[i] * r1; ss += o[i] * o[i]; }
    ssq[q][eg] = ss; __syncthreads();
    const float tot = ssq[q][0] + ssq[q][1] + ssq[q][2] + ssq[q][3]; const float rs = 1.f / sqrtf(tot * (1.f / 128.f) + EPS) * oml;
    const float* sg = p.in[19];
    float ov[32];
#pragma unroll
    for (int i = 0; i < 32; ++i) ov[i] = o[i] * rs * sg[eg * 32 + i];
    bf16* O = (bf16*)(p.ws + WS_R2) + t * D + head * 128 + eg * 32;
#pragma unroll
    for (int i = 0; i < 32; i += 8) *(u32x4*)(O + i) = pack8(ov + i);
}

#ifndef LAUNCH_MODE
#define LAUNCH_MODE 2
#endif
extern "C" void kernel_launch(void* const* d_in, const int* in_sizes, int n_in, void* d_out, int out_size, void* d_ws, size_t ws_size, hipStream_t stream) {
    static int grid = 0;
    if (grid == 0) {
        if (n_in != 28 || out_size != T * D || ws_size < WS_END) { fprintf(stderr, "kernel_launch: unexpected shapes n_in %d out %d ws %zu\n", n_in, out_size, ws_size); grid = -1; return; }
        int dev = 0, cus = 0;
        if (hipGetDevice(&dev) != hipSuccess || hipDeviceGetAttribute(&cus, hipDeviceAttributeMultiprocessorCount, dev) != hipSuccess) { grid = -1; return; }
        if (hipFuncSetAttribute((const void*)fwd, hipFuncAttributeMaxDynamicSharedMemorySize, LDS_BYTES) != hipSuccess) { fprintf(stderr, "kernel_launch: hipFuncSetAttribute failed\n"); grid = -1; return; }
        int per_cu = 0; (void)hipOccupancyMaxActiveBlocksPerMultiprocessor(&per_cu, (const void*)fwd, 512, LDS_BYTES); (void)hipGetLastError();
        if (per_cu < 1) fprintf(stderr, "kernel_launch: occupancy query says %d\n", per_cu);
        grid = cus;
    }
    if (grid < 0) return;
    Args a{}; for (int i = 0; i < 28; ++i) a.p.in[i] = (const float*)d_in[i]; a.p.out = (float*)d_out; a.p.ws = (unsigned char*)d_ws;
    (void)hipMemsetAsync((char*)d_ws + WS_CTL, 0, CTL_ZERO_BYTES, stream);
    auto run = [&](int lo, int hi, int li) { a.ph_lo = lo; a.ph_hi = hi; a.li = li; hipLaunchKernelGGL(fwd, dim3(grid), dim3(512), LDS_BYTES, stream, a); };
#if LAUNCH_MODE == 0
    for (int ph = 0; ph < NPHASE; ++ph) { if (ph == 11) hipLaunchKernelGGL(k_naive_attn, dim3(NB * NH * 64), dim3(256), 0, stream, a.p); else run(ph, ph + 1, 0); }
#elif LAUNCH_MODE == 1
    run(0, 11, 0); hipLaunchKernelGGL(k_naive_attn, dim3(NB * NH * 64), dim3(256), 0, stream, a.p); run(12, 17, 1);
#else
    run(0, NPHASE, 0);
#endif
}
```

```cpp
#include <hip/hip_runtime.h>
#include <cstdio>
#include <cstdint>
#include <cmath>

#define LAS __attribute__((address_space(3)))
typedef unsigned short bf16;
typedef float f32x4 __attribute__((ext_vector_type(4)));
typedef unsigned u32x4 __attribute__((ext_vector_type(4)));
typedef short bf16x8 __attribute__((ext_vector_type(8)));

constexpr int NB = 8, SEQ = 4096, T = NB * SEQ, D = 1024;
constexpr int SG = 64, SP = 64, SH = 16, CS = 16, NCR = T / CS, UXP = 384;
constexpr int NH = 8, HD = 64, VD = 128;
constexpr int NE = 32, FE = 256;
constexpr float EPS = 1e-6f;
constexpr float LOG2E = 1.4426950408889634f;
constexpr float QSCALE = 0.125f * LOG2E;

constexpr size_t MiB = 1u << 20;
constexpr size_t WS_CTL = 0, CTL_ZERO_BYTES = 1 * MiB;
constexpr size_t WS_CONST = 1 * MiB;
constexpr size_t WS_ROPE = 2 * MiB;
constexpr size_t WS_WIN = 4 * MiB, WS_WGLU = 6 * MiB, WS_WQKV = 10 * MiB, WS_WO = 16 * MiB;
constexpr size_t WS_MG = 18 * MiB;
constexpr size_t WS_TE = 22 * MiB;
constexpr size_t WS_WGU = 34 * MiB;
constexpr size_t WS_WD = 98 * MiB;
constexpr size_t WS_LIST = 130 * MiB;
constexpr size_t WS_R1 = 138 * MiB;
constexpr size_t WS_R2 = 202 * MiB;
constexpr size_t WS_R3 = 330 * MiB;
constexpr size_t WS_END = 394 * MiB;
constexpr int CW_BAR = 4096;
constexpr int CW_CNT = 16384;

constexpr int RING_BYTES = 131072;
constexpr int TAB_OFF = 147456;
constexpr int MISC_OFF = TAB_OFF + 1024;
constexpr int LDS_BYTES = 163840;

struct Params { const float* in[28]; float* out; unsigned char* ws; };

__device__ __forceinline__ unsigned f2bf(float f) { unsigned u = __builtin_bit_cast(unsigned, f); return (u + 0x7fffu + ((u >> 16) & 1u)) >> 16; }
__device__ __forceinline__ float bf2f(unsigned b) { return __builtin_bit_cast(float, b << 16); }
__device__ __forceinline__ unsigned pk2(float lo, float hi) { return f2bf(lo) | (f2bf(hi) << 16); }
__device__ __forceinline__ u32x4 pack8(const float* v) { u32x4 w; w.x = pk2(v[0], v[1]); w.y = pk2(v[2], v[3]); w.z = pk2(v[4], v[5]); w.w = pk2(v[6], v[7]); return w; }
__device__ __forceinline__ void unpack8(u32x4 w, float* v) { v[0] = bf2f(w.x & 0xffffu); v[1] = bf2f(w.x >> 16); v[2] = bf2f(w.y & 0xffffu); v[3] = bf2f(w.y >> 16);
    v[4] = bf2f(w.z & 0xffffu); v[5] = bf2f(w.z >> 16); v[6] = bf2f(w.w & 0xffffu); v[7] = bf2f(w.w >> 16); }
__device__ __forceinline__ float wave_sum(float v) {
#pragma unroll
    for (int o = 1; o < 64; o <<= 1) v += __shfl_xor(v, o);
    return v;
}
__device__ __forceinline__ float gelu_tanh(float x) { const float u = 0.7978845608028654f * (x + 0.044715f * x * x * x); const float e = __expf(2.f * u); const float th = 1.f - 2.f / (e + 1.f); return 0.5f * x * (1.f + th); }
__device__ __forceinline__ float sigmoidf_(float x) { return 1.f / (1.f + __expf(-x)); }

struct GUnit { int pm, pn, e, aux, cnt, pad; };
__device__ __forceinline__ int xcd_remap(int L, int nwg) { const int q = nwg >> 3, r = nwg & 7, xcd = L & 7, off = L >> 3; return (xcd < r ? xcd * (q + 1) : r * (q + 1) + (xcd - r) * q) + off; }

struct SchedDense {
    static constexpr bool GATHER = false;
    const bf16* A; const bf16* Bt; int nN, K, amode, pad;
    __device__ __forceinline__ bool next(int i, int G, int c, GUnit& u, const LAS int*) const {
        const int nM = T / 256, nwg = nM * nN; const long L = (long)i * G + c; if (L >= nwg) return false;
        const int wgid = xcd_remap((int)L, nwg);
        const int nig = 8 * nN, gid = wgid / nig, fm = gid * 8, gsz = (nM - fm) < 8 ? (nM - fm) : 8;
        u.pm = fm + ((wgid % nig) % gsz); u.pn = (wgid % nig) / gsz; u.e = 0; u.aux = 0; u.cnt = 256; u.pad = 0; return true; }
    __device__ __forceinline__ const char* abase(const GUnit& u) const { return (const char*)(amode == 0 ? A + (size_t)u.pm * 256 * K : A + (size_t)u.pm * 256 * 16); }
    __device__ __forceinline__ unsigned avoff(const GUnit&, int Rr, int C) const { return amode == 0 ? (unsigned)(Rr * K + C) * 2u : (unsigned)((C >> 4) * (T * 16) + Rr * 16 + (C & 15)) * 2u; }
    __device__ __forceinline__ size_t kstepA() const { return amode == 0 ? (size_t)128 : (size_t)4 * T * 16 * 2; }
    __device__ __forceinline__ const char* bbase(const GUnit& u) const { return (const char*)(Bt + (size_t)u.pn * 256 * K); }
    __device__ __forceinline__ size_t hstepB() const { return (size_t)128 * K * 2; }
};
struct SchedSsm {
    static constexpr bool GATHER = false;
    const bf16* UX; const bf16* Bt; int K, brows;
    __device__ __forceinline__ bool next(int i, int G, int c, GUnit& u, const LAS int*) const {
        const int nwg = SG * (NCR / 256); const long L = (long)i * G + c; if (L >= nwg) return false;
        const int wgid = xcd_remap((int)L, nwg); u.e = wgid >> 3; u.pm = wgid & 7; u.pn = 0; u.aux = 0; u.cnt = 256; u.pad = 0; return true; }
    __device__ __forceinline__ const char* abase(const GUnit& u) const { return (const char*)(UX + ((size_t)u.e * NCR + (size_t)u.pm * 256) * UXP); }
    __device__ __forceinline__ unsigned avoff(const GUnit&, int Rr, int C) const { return (unsigned)(Rr * UXP + C) * 2u; }
    __device__ __forceinline__ size_t kstepA() const { return 128; }
    __device__ __forceinline__ const char* bbase(const GUnit& u) const { return (const char*)(Bt + (size_t)u.e * brows * K); }
    __device__ __forceinline__ size_t hstepB() const { return brows == 256 ? (size_t)128 * K * 2 : 0; }
};
template <int PHASE> struct SchedMoe {
    const bf16* A; const bf16* Bt; const int* list; long pad;
    static constexpr bool GATHER = (PHASE == 1);
    static constexpr int NPN = PHASE == 1 ? 2 : 4, KK = PHASE == 1 ? 1024 : 256, BROWS = PHASE == 1 ? 512 : 1024;
    int K;  int pad2;
    __device__ __forceinline__ bool next(int i, int G, int c, GUnit& u, const LAS int* tab) const {
        const int nwg = tab[32] * NPN; const long L = (long)i * G + c; if (L >= nwg) return false;
        const int wgid = xcd_remap((int)L, nwg); const int j = wgid / NPN; u.pn = wgid % NPN;
        int e = 0;
#pragma unroll 1
        for (int k = 1; k < NE; ++k) e = (j >= tab[k]) ? k : e;
        u.e = e; u.pm = j - tab[e]; u.aux = j * 256; u.cnt = tab[64 + e]; u.pad = 0; return true; }
    __device__ __forceinline__ const char* abase(const GUnit& u) const { return (const char*)(PHASE == 1 ? A : A + (size_t)u.aux * FE); }
    __device__ __forceinline__ unsigned avoff(const GUnit& u, int Rr, int C) const {
        if (PHASE == 1) { const int ri = u.pm * 256 + Rr; const int tok = ri < u.cnt ? (list[(size_t)u.e * T + ri] >> 1) : 0; return (unsigned)(tok * D + C) * 2u; }
        return (unsigned)(Rr * FE + C) * 2u; }
    __device__ __forceinline__ size_t kstepA() const { return 128; }
    __device__ __forceinline__ const char* bbase(const GUnit& u) const { return (const char*)(Bt + ((size_t)u.e * BROWS + (size_t)u.pn * 256) * KK); }
    __device__ __forceinline__ size_t hstepB() const { return (size_t)128 * KK * 2; }
};

struct EpiWin { bf16* UX;
    __device__ __forceinline__ void operator()(const GUnit& u, int r, int wc, int fq, const float (&v0)[8], const float (&v1)[8]) const {
        const int t = u.pm * 256 + r, n = t >> 4, s = t & 15;
#pragma unroll
        for (int hb = 0; hb < 2; ++hb) { const int c = u.pn * 256 + hb * 128 + wc * 32 + fq * 8, g = c >> 4, hh = c & 15;
            *(u32x4*)(UX + ((size_t)g * NCR + n) * UXP + s * 16 + hh) = pack8(hb ? v1 : v0); }
    } };
struct EpiSsmA { float* SLOC;
    __device__ __forceinline__ void operator()(const GUnit& u, int r, int wc, int fq, const float (&v0)[8], const float (&v1)[8]) const {
        float* o = SLOC + ((size_t)u.e * NCR + (size_t)u.pm * 256 + r) * 128 + wc * 32 + fq * 8;
        *(f32x4*)o = (f32x4){v0[0], v0[1], v0[2], v0[3]}; *(f32x4*)(o + 4) = (f32x4){v0[4], v0[5], v0[6], v0[7]};
    } };
struct EpiSsmC { bf16* G;
    __device__ __forceinline__ void operator()(const GUnit& u, int r, int wc, int fq, const float (&v0)[8], const float (&v1)[8]) const {
        const int n = u.pm * 256 + r;
#pragma unroll
        for (int hb = 0; hb < 2; ++hb) { const int j = hb * 128 + wc * 32 + fq * 8, tt = j >> 4, ho = j & 15; const size_t tok = (size_t)n * 16 + tt;
            float g[8];
#pragma unroll
            for (int i = 0; i < 8; ++i) g[i] = gelu_tanh(hb ? v1[i] : v0[i]);
            *(u32x4*)(G + ((size_t)u.e * T + tok) * 16 + ho) = pack8(g); }
    } };
struct EpiGlu { const float* xin; float* X;
    __device__ __forceinline__ void operator()(const GUnit& u, int r, int wc, int fq, const float (&v0)[8], const float (&v1)[8]) const {
        const size_t o = ((size_t)u.pm * 256 + r) * D + u.pn * 128 + wc * 32 + fq * 8;
        const f32x4 a = *(const f32x4*)(xin + o), b = *(const f32x4*)(xin + o + 4);
        float m[8];
#pragma unroll
        for (int i = 0; i < 8; ++i) m[i] = v0[i] * sigmoidf_(v1[i]);
        *(f32x4*)(X + o) = (f32x4){a.x + m[0], a.y + m[1], a.z + m[2], a.w + m[3]}; *(f32x4*)(X + o + 4) = (f32x4){b.x + m[4], b.y + m[5], b.z + m[6], b.w + m[7]};
    } };
struct EpiMoe1 { bf16* HID; const float* wl;
    __device__ __forceinline__ void operator()(const GUnit& u, int r, int wc, int fq, const float (&v0)[8], const float (&v1)[8]) const {
        const int ri = u.pm * 256 + r; const float w = ri < u.cnt ? wl[(size_t)u.e * T + ri] : 0.f;
        float h[8];
#pragma unroll
        for (int i = 0; i < 8; ++i) h[i] = v0[i] * sigmoidf_(v0[i]) * v1[i] * w;
        *(u32x4*)(HID + ((size_t)u.aux + r) * FE + u.pn * 128 + wc * 32 + fq * 8) = pack8(h);
    } };
struct EpiMoe2 { bf16* CBUF; const int* list;
    __device__ __forceinline__ void operator()(const GUnit& u, int r, int wc, int fq, const float (&v0)[8], const float (&v1)[8]) const {
        const int ri = u.pm * 256 + r; if (ri >= u.cnt) return;
        const int ent = list[(size_t)u.e * T + ri]; const size_t tok = ent >> 1, slot = ent & 1;
        bf16* o = CBUF + (slot * T + tok) * D + u.pn * 256 + wc * 32 + fq * 8;
        *(u32x4*)o = pack8(v0); *(u32x4*)(o + 128) = pack8(v1);
    } };
struct EpiQkv { bf16* Q; bf16* KIMG; bf16* VIMG; const float* ropec; const float* ropes;
    __device__ __forceinline__ void operator()(const GUnit& u, int r, int wc, int fq, const float (&v0)[8], const float (&v1)[8]) const {
        const int t = u.pm * 256 + r, pos = t & (SEQ - 1), b = t >> 12;
        if (u.pn < 8) {
            const f32x4 c0 = *(const f32x4*)(ropec + pos * 32 + fq * 8), c1 = *(const f32x4*)(ropec + pos * 32 + fq * 8 + 4);
            const f32x4 s0 = *(const f32x4*)(ropes + pos * 32 + fq * 8), s1 = *(const f32x4*)(ropes + pos * 32 + fq * 8 + 4);
            const float cs[8] = {c0.x, c0.y, c0.z, c0.w, c1.x, c1.y, c1.z, c1.w}, sn[8] = {s0.x, s0.y, s0.z, s0.w, s1.x, s1.y, s1.z, s1.w};
            const float sc = u.pn < 4 ? QSCALE : 1.f;
            float o1[8], o2[8];
#pragma unroll
            for (int i = 0; i < 8; ++i) { o1[i] = (v0[i] * cs[i] - v1[i] * sn[i]) * sc; o2[i] = (v1[i] * cs[i] + v0[i] * sn[i]) * sc; }
            const int head = 2 * (u.pn & 3) + (wc >> 1), c = wc & 1;
            if (u.pn < 4) { bf16* o = Q + (size_t)t * D + head * 128 + c * 64 + fq * 8; *(u32x4*)o = pack8(o1); *(u32x4*)(o + 32) = pack8(o2); }
            else { bf16* o = KIMG + (((size_t)(b * NH + head) * 64 + (pos >> 6)) * 8192) + (size_t)(c * 8 + fq) * 512 + (pos & 63) * 8;
                *(u32x4*)o = pack8(o1); *(u32x4*)(o + 4 * 512) = pack8(o2); }
        } else {
#pragma unroll
            for (int hb = 0; hb < 2; ++hb) { const int head = 2 * (u.pn - 8) + hb;
                bf16* o = VIMG + (((size_t)(b * NH + head) * 64 + (pos >> 6)) * 8192) + wc * 2048 + ((pos & 63) >> 4) * 512 + (pos & 15) * 32 + fq * 8;
                *(u32x4*)o = pack8(hb ? v1 : v0); }
        }
    } };
struct EpiWo { float* X;
    __device__ __forceinline__ void operator()(const GUnit& u, int r, int wc, int fq, const float (&v0)[8], const float (&v1)[8]) const {
        float* o = X + ((size_t)u.pm * 256 + r) * D + u.pn * 256 + wc * 32 + fq * 8;
#pragma unroll
        for (int hb = 0; hb < 2; ++hb) { float* p = o + hb * 128; const float* v = hb ? v1 : v0; f32x4 a = *(f32x4*)p, b = *(f32x4*)(p + 4);
            a.x += v[0]; a.y += v[1]; a.z += v[2]; a.w += v[3]; b.x += v[4]; b.y += v[5]; b.z += v[6]; b.w += v[7]; *(f32x4*)p = a; *(f32x4*)(p + 4) = b; }
    } };

namespace pg {
constexpr int BK = 64, HALF = 128, HTB = HALF * BK * 2;
__device__ __forceinline__ int lds_byte(int r, int c) { const int st = (r >> 4) * 2 + (c >> 5), rr = r & 15, cc = c & 31, ob = rr * 64 + cc * 2; return st * 1024 + (ob ^ (((ob >> 9) & 1) << 5)); }
__device__ __forceinline__ void stage_rc(int b, int& R, int& C) { const int st = b / 1024, sb = b % 1024, swz = sb ^ (((sb >> 9) & 1) << 5); R = (st >> 1) * 16 + swz / 64; C = (st & 1) * 32 + (swz % 64) / 2; }
__device__ __forceinline__ int perm32(int rho) { const int n = rho >> 4, i = rho & 15; return 8 * (i >> 2) + 4 * n + (i & 3); }

template <class Sched, class Epi, bool ALIGN_EPI>
__device__ __forceinline__ void gemm_phase(LAS unsigned char* lds, const Sched& S, const Epi& E, int G, int c, const LAS int* tab) {
    int tid = threadIdx.x; asm volatile("" : "+v"(tid));
    const int wid = __builtin_amdgcn_readfirstlane(tid >> 6), lane = tid & 63, wr = wid >> 2, wc = wid & 3, fr = lane & 15, fq = lane >> 4;
    const int K = S.K, nt = K / BK;
    int R[2], C[2]; unsigned voffB[2];
#pragma unroll
    for (int i = 0; i < 2; ++i) { stage_rc(tid * 16 + i * 8192, R[i], C[i]); const int Rb = (R[i] & ~31) + perm32(R[i] & 31); voffB[i] = (unsigned)(Rb * K + C[i]) * 2u; }
    const size_t kstepA = S.kstepA(), hstepB = S.hstepB();
    const unsigned ldsw = (unsigned)wid * 1024u;
    const int aoff = lds_byte(wr * 64 + fr, fq * 8), boff = lds_byte(wc * 32 + fr, fq * 8);
#define PG_SA(b, h) (((b) * 2 + (h)) * HTB)
#define PG_SB(b, h) ((4 + (b) * 2 + (h)) * HTB)
#define PG_STAGE(bufoff, gbase, voff) do { _Pragma("unroll") for (int _i = 0; _i < 2; ++_i) \
        __builtin_amdgcn_global_load_lds((const unsigned*)((const char*)(gbase) + (voff)[_i]), (LAS unsigned*)(lds + (bufoff) + ldsw + _i * 8192), 16, 0, 0); } while (0)
#define PG_LDA(dst, b, h) do { _Pragma("unroll") for (int m = 0; m < 4; ++m) _Pragma("unroll") for (int k = 0; k < 2; ++k) dst[m][k] = *(const LAS bf16x8*)(lds + PG_SA(b, h) + aoff + m * 2048 + k * 1024); } while (0)
#define PG_LDB(dst, b, h) do { _Pragma("unroll") for (int n = 0; n < 2; ++n) _Pragma("unroll") for (int k = 0; k < 2; ++k) dst[n][k] = *(const LAS bf16x8*)(lds + PG_SB(b, h) + boff + n * 2048 + k * 1024); } while (0)
#define PG_MMA(ai, bj, At, Bt) do { __builtin_amdgcn_s_setprio(1); _Pragma("unroll") for (int m = 0; m < 4; ++m) _Pragma("unroll") for (int n = 0; n < 2; ++n) _Pragma("unroll") for (int k = 0; k < 2; ++k) \
        acc[ai][bj][m][n] = __builtin_amdgcn_mfma_f32_16x16x32_bf16(Bt[n][k], At[m][k], acc[ai][bj][m][n], 0, 0, 0); __builtin_amdgcn_s_setprio(0); } while (0)
#define PG_WAIT_V(n) asm volatile("s_waitcnt vmcnt(" #n ")" ::: "memory")
#define PG_WAIT_L(n) asm volatile("s_waitcnt lgkmcnt(" #n ")" ::: "memory")
#define PG_BAR __builtin_amdgcn_s_barrier()
#define PG_SCHED __builtin_amdgcn_sched_barrier(0)
    GUnit cur, nxt; int ui = 0;
    if (!S.next(0, G, c, cur, tab)) return;
    unsigned voffA[2][2];
#pragma unroll
    for (int h = 0; h < 2; ++h)
#pragma unroll
        for (int i = 0; i < 2; ++i) voffA[h][i] = S.avoff(cur, h * 128 + R[i], C[i]);
    f32x4 acc[2][2][4][2];
#pragma unroll
    for (int a = 0; a < 2; ++a)
#pragma unroll
        for (int b = 0; b < 2; ++b)
#pragma unroll
            for (int m = 0; m < 4; ++m)
#pragma unroll
                for (int n = 0; n < 2; ++n) acc[a][b][m][n] = (f32x4){0.f, 0.f, 0.f, 0.f};
    bf16x8 At[4][2], B0[2][2], B1[2][2];
    const char* cA = S.abase(cur); const char* cB = S.bbase(cur);
    PG_STAGE(PG_SB(0, 0), cB, voffB); PG_STAGE(PG_SB(0, 1), cB + hstepB, voffB); PG_STAGE(PG_SA(0, 0), cA, voffA[0]); PG_STAGE(PG_SA(0, 1), cA, voffA[1]);
    if (wr == 1) PG_BAR;
    PG_WAIT_V(2); PG_BAR;
    PG_STAGE(PG_SB(1, 0), cB + 128, voffB); PG_STAGE(PG_SA(1, 0), cA + kstepA, voffA[0]); PG_STAGE(PG_SB(1, 1), cB + hstepB + 128, voffB);
    PG_WAIT_V(6); PG_BAR;
    for (;;) {
        const bool has_next = S.next(ui + 1, G, c, nxt, tab);
        const char* nA = has_next ? S.abase(nxt) : cA; const char* nB = has_next ? S.bbase(nxt) : cB;
        for (int t = 0; t < nt; t += 2) {
            const bool last = (t == nt - 2);
            const char* a1 = cA + (size_t)(t + 1) * kstepA;
            const char* a2 = last ? nA : cA + (size_t)(t + 2) * kstepA; const char* b2 = last ? nB : cB + (size_t)(t + 2) * 128;
            const char* a3 = a2 + kstepA; const char* b3 = b2 + 128;
            if (Sched::GATHER && last && has_next) {
#pragma unroll
                for (int i = 0; i < 2; ++i) voffA[0][i] = S.avoff(nxt, R[i], C[i]); }
            PG_LDB(B0, 0, 0); PG_LDB(B1, 0, 1); PG_SCHED; PG_LDA(At, 0, 0); PG_STAGE(PG_SA(1, 1), a1, voffA[1]);
            if (Sched::GATHER && last && has_next) {
#pragma unroll
                for (int i = 0; i < 2; ++i) voffA[1][i] = S.avoff(nxt, 128 + R[i], C[i]); }
            PG_WAIT_V(8); PG_WAIT_L(0); PG_BAR; PG_MMA(0, 0, At, B0); PG_MMA(0, 1, At, B1); PG_BAR; PG_SCHED;
            PG_LDA(At, 0, 1); PG_STAGE(PG_SB(0, 0), b2, voffB); PG_STAGE(PG_SB(0, 1), b2 + hstepB, voffB); PG_STAGE(PG_SA(0, 0), a2, voffA[0]);
            PG_WAIT_V(8); PG_WAIT_L(0); PG_BAR; PG_MMA(1, 0, At, B0); PG_MMA(1, 1, At, B1); PG_BAR; PG_SCHED;
            PG_LDB(B0, 1, 0); PG_LDB(B1, 1, 1); PG_SCHED; PG_LDA(At, 1, 0); PG_STAGE(PG_SA(0, 1), a2, voffA[1]);
            PG_WAIT_V(8); PG_WAIT_L(0); PG_BAR; PG_MMA(0, 0, At, B0); PG_MMA(0, 1, At, B1); PG_BAR; PG_SCHED;
            PG_LDA(At, 1, 1); PG_STAGE(PG_SB(1, 0), b3, voffB); PG_STAGE(PG_SB(1, 1), b3 + hstepB, voffB); PG_STAGE(PG_SA(1, 0), a3, voffA[0]);
            PG_WAIT_V(8); PG_WAIT_L(0); PG_BAR; PG_MMA(1, 0, At, B0); PG_MMA(1, 1, At, B1); PG_BAR; PG_SCHED;
        }
        if constexpr (ALIGN_EPI) { if (wr == 0) PG_BAR; }
        int frE = fr, fqE = fq; asm volatile("" : "+v"(frE), "+v"(fqE));
#pragma unroll
        for (int ai = 0; ai < 2; ++ai)
#pragma unroll
            for (int m = 0; m < 4; ++m) {
                const float v0[8] = {acc[ai][0][m][0][0], acc[ai][0][m][0][1], acc[ai][0][m][0][2], acc[ai][0][m][0][3], acc[ai][0][m][1][0], acc[ai][0][m][1][1], acc[ai][0][m][1][2], acc[ai][0][m][1][3]};
                const float v1[8] = {acc[ai][1][m][0][0], acc[ai][1][m][0][1], acc[ai][1][m][0][2], acc[ai][1][m][0][3], acc[ai][1][m][1][0], acc[ai][1][m][1][1], acc[ai][1][m][1][2], acc[ai][1][m][1][3]};
                E(cur, ai * 128 + wr * 64 + m * 16 + frE, wc, fqE, v0, v1);
            }
        if (!has_next) break;
#pragma unroll
        for (int a = 0; a < 2; ++a)
#pragma unroll
            for (int b = 0; b < 2; ++b)
#pragma unroll
                for (int m = 0; m < 4; ++m)
#pragma unroll
                    for (int n = 0; n < 2; ++n) acc[a][b][m][n] = (f32x4){0.f, 0.f, 0.f, 0.f};
        cur = nxt; cA = nA; cB = nB; ++ui;
        if constexpr (ALIGN_EPI) { if (wr == 1) PG_BAR; }
    }
    PG_WAIT_V(0);
    if constexpr (!ALIGN_EPI) { if (wr == 0) PG_BAR; }
    PG_BAR;
#undef PG_SA
#undef PG_SB
#undef PG_STAGE
#undef PG_LDA
#undef PG_LDB
#undef PG_MMA
#undef PG_WAIT_V
#undef PG_WAIT_L
#undef PG_BAR
#undef PG_SCHED
}
}


namespace at {
typedef float f32x16 __attribute__((ext_vector_type(16)));
typedef short s16x4 __attribute__((ext_vector_type(4)));
typedef short v4i16_t __attribute__((ext_vector_type(4)));
typedef float f32x2_t __attribute__((ext_vector_type(2))); typedef __bf16 bf16x2_t __attribute__((ext_vector_type(2)));
constexpr int STG = 32768, WSF_OFF = 3 * 32768;
__device__ __forceinline__ int crow(int r, int hi) { return (r & 3) + 8 * (r >> 2) + 4 * hi; }
__device__ __forceinline__ void glds16(const void* gsrc, unsigned lds_dst) { unsigned keep;
    asm volatile("s_mov_b32 %0, m0\n\ts_mov_b32 m0, %2\n\ts_nop 0\n\tglobal_load_lds_dwordx4 %1, off\n\ts_mov_b32 m0, %0" : "=&s"(keep) : "v"(gsrc), "s"(lds_dst) : "memory"); }
__device__ __forceinline__ unsigned cvtpk(float lo, float hi) { f32x2_t v = {lo, hi}; bf16x2_t b = __builtin_convertvector(v, bf16x2_t); return __builtin_bit_cast(unsigned, b); }
__device__ __forceinline__ s16x4 vtr(const LAS unsigned char* p) { return __builtin_bit_cast(s16x4, __builtin_amdgcn_ds_read_tr16_b64_v4i16((LAS v4i16_t*)p)); }
__device__ __forceinline__ float swapmax(float v) { auto rr = __builtin_amdgcn_permlane32_swap(__float_as_uint(v), __float_as_uint(v), false, false); return fmaxf(__uint_as_float(rr[0]), __uint_as_float(rr[1])); }
__device__ __forceinline__ float swapadd(float v) { auto rr = __builtin_amdgcn_permlane32_swap(__float_as_uint(v), __float_as_uint(v), false, false); return __uint_as_float(rr[0]) + __uint_as_float(rr[1]); }
#define AT_WAIT_BAR() asm volatile("s_waitcnt vmcnt(0) lgkmcnt(0)\n\ts_barrier" ::: "memory")
#define AT_LWAIT() asm volatile("s_waitcnt lgkmcnt(0)" ::: "memory")

template <int THR>
__device__ __forceinline__ void attn_unit(const bf16* Q, const bf16* KIMG, const bf16* VIMG, bf16* O, const float* subg, float lam, float oml, int bh, int qb, LAS unsigned char* L, int wid, int lane_in) {
    int lane = lane_in; asm volatile("" : "+v"(lane));
    const int r32 = lane & 31, hi = lane >> 5, qg = wid >> 1, c = wid & 1, b = bh >> 3, head = bh & 7;
    const size_t qrow = (size_t)b * SEQ + qb * 128 + qg * 32;
    const int NT = 2 * qb + 2, myNT = 2 * qb + 1 + (qg >> 1);
    const unsigned lbase = (unsigned)(size_t)L;
    const char* kt0 = (const char*)(KIMG + (size_t)bh * 64 * 8192) + wid * 1024 + lane * 16;
    const char* vt0 = (const char*)(VIMG + (size_t)bh * 64 * 8192) + wid * 1024 + lane * 16;
#define AT_DMA(t, soff) do { const unsigned d_ = (unsigned)__builtin_amdgcn_readfirstlane(lbase + (soff) + wid * 1024); const size_t o_ = (size_t)(t) * 16384; \
        glds16(kt0 + o_, d_); glds16(kt0 + o_ + 8192, d_ + 8192); glds16(vt0 + o_, d_ + 16384); glds16(vt0 + o_ + 8192, d_ + 16384 + 8192); } while (0)
    AT_DMA(0, 0); AT_DMA(1, STG); if (NT > 2) AT_DMA(2, 2 * STG);
    bf16x8 qr[4];
#pragma unroll
    for (int d0 = 0; d0 < 4; ++d0) qr[d0] = *(const bf16x8*)(Q + (qrow + r32) * D + head * 128 + c * 64 + d0 * 16 + hi * 8);
    f32x16 o[4];
#pragma unroll
    for (int db = 0; db < 4; ++db)
#pragma unroll
        for (int r = 0; r < 16; ++r) o[db][r] = 0.f;
    float m = -1e30f, l = 0.f;
    LAS float* wsf = (LAS float*)(L + WSF_OFF) + wid * 64;
    const int vlo = ((lane >> 4) & 1) * 32 + (lane & 3) * 8 + (4 * hi + ((lane & 15) >> 2)) * 64;
    const int klo = (c * 8 + hi) * 1024 + r32 * 16;
#define SBAR() __builtin_amdgcn_sched_barrier(0)
#define AT_KRD(K0, K1, soff, d0) do { const LAS unsigned char* kp_ = L + (soff) + klo + (d0) * 2048; K0 = *(const LAS bf16x8*)kp_; K1 = *(const LAS bf16x8*)(kp_ + 512); } while (0)
#define AT_VRD(VF, soff, ks) do { const LAS unsigned char* vb_ = L + (soff) + 16384 + vlo + (ks) * 1024; \
        _Pragma("unroll") for (int db = 0; db < 4; ++db) { const s16x4 a_ = vtr(vb_ + db * 4096), b_ = vtr(vb_ + db * 4096 + 512); VF[db] = (bf16x8){a_[0], a_[1], a_[2], a_[3], b_[0], b_[1], b_[2], b_[3]}; } } while (0)
#define AT_QKM(P0, P1, K0, K1, d0) do { P0 = __builtin_amdgcn_mfma_f32_32x32x16_bf16(K0, qr[d0], P0, 0, 0, 0); P1 = __builtin_amdgcn_mfma_f32_32x32x16_bf16(K1, qr[d0], P1, 0, 0, 0); } while (0)
#define AT_QKZ(P0, P1, K0, K1) do { const f32x16 z_ = {0.f, 0.f, 0.f, 0.f, 0.f, 0.f, 0.f, 0.f, 0.f, 0.f, 0.f, 0.f, 0.f, 0.f, 0.f, 0.f}; P0 = __builtin_amdgcn_mfma_f32_32x32x16_bf16(K0, qr[0], z_, 0, 0, 0); P1 = __builtin_amdgcn_mfma_f32_32x32x16_bf16(K1, qr[0], z_, 0, 0, 0); } while (0)
#define AT_PVM(VF, ks) do { const bf16x8 pa_ = __builtin_bit_cast(bf16x8, pw[ks]); \
        _Pragma("unroll") for (int db = 0; db < 4; ++db) o[db] = __builtin_amdgcn_mfma_f32_32x32x16_bf16(pa_, VF[db], o[db], 0, 0, 0); } while (0)
#define AT_CHUNK(P, base, PW) do { \
        _Pragma("unroll") for (int r = (base); r < (base) + 8; ++r) { P[r] = __builtin_amdgcn_exp2f(P[r] - m); sacc += P[r]; } \
        _Pragma("unroll") for (int i = 0; i < 4; ++i) PW[i] = cvtpk(P[(base) + 2 * i], P[(base) + 2 * i + 1]); } while (0)
#define AT_ROWMAX(P0, P1) do { rm = fmaxf(P0[0], P1[0]); \
        _Pragma("unroll") for (int r = 1; r < 16; ++r) rm = fmaxf(rm, fmaxf(P0[r], P1[r])); \
        rm = swapmax(rm); } while (0)
#define AT_DECIDE() do { if (__any(rm > m + (float)THR)) { \
            const float mn = fmaxf(m, rm); const float alpha = __builtin_amdgcn_exp2f(m - mn); m = mn; l *= alpha; \
            if (hi == 0) wsf[r32] = alpha; \
            AT_LWAIT(); \
            _Pragma("unroll") for (int r = 0; r < 16; ++r) { const float a = wsf[crow(r, hi)]; \
                _Pragma("unroll") for (int db = 0; db < 4; ++db) o[db][r] *= a; } \
            AT_LWAIT(); } } while (0)
#define AT_ZERO(P0, P1) do { _Pragma("unroll") for (int r = 0; r < 16; ++r) { P0[r] = 0.f; P1[r] = 0.f; } } while (0)
#define AT_STEPF(CUR0, CUR1, NXT0, NXT1) do { float rm, sacc = 0.f; \
            AT_KRD(kA0, kA1, s1, 0); AT_ROWMAX(CUR0, CUR1); AT_DECIDE(); SBAR(); AT_QKZ(NXT0, NXT1, kA0, kA1); SBAR(); \
            AT_KRD(kA0, kA1, s1, 1); SBAR(); AT_CHUNK(CUR0, 0, pw[0]); SBAR(); AT_QKM(NXT0, NXT1, kA0, kA1, 1); SBAR(); \
            AT_KRD(kA0, kA1, s1, 2); SBAR(); AT_CHUNK(CUR0, 8, pw[1]); SBAR(); AT_QKM(NXT0, NXT1, kA0, kA1, 2); SBAR(); \
            AT_KRD(kA0, kA1, s1, 3); AT_VRD(vA, s0, 0); SBAR(); AT_CHUNK(CUR1, 0, pw[2]); SBAR(); AT_QKM(NXT0, NXT1, kA0, kA1, 3); SBAR(); \
            AT_PVM(vA, 0); SBAR(); AT_VRD(vA, s0, 1); AT_CHUNK(CUR1, 8, pw[3]); SBAR(); \
            AT_PVM(vA, 1); SBAR(); AT_VRD(vA, s0, 2); SBAR(); \
            AT_PVM(vA, 2); SBAR(); AT_VRD(vA, s0, 3); SBAR(); \
            AT_PVM(vA, 3); l += sacc; SBAR(); } while (0)
#define AT_STEPT(CUR0, CUR1) do { float rm, sacc = 0.f; \
            AT_VRD(vA, s0, 0); AT_ROWMAX(CUR0, CUR1); AT_DECIDE(); SBAR(); \
            AT_CHUNK(CUR0, 0, pw[0]); AT_CHUNK(CUR0, 8, pw[1]); SBAR(); \
            AT_PVM(vA, 0); SBAR(); AT_VRD(vA, s0, 1); AT_CHUNK(CUR1, 0, pw[2]); SBAR(); \
            AT_PVM(vA, 1); SBAR(); AT_VRD(vA, s0, 2); AT_CHUNK(CUR1, 8, pw[3]); SBAR(); \
            AT_PVM(vA, 2); SBAR(); AT_VRD(vA, s0, 3); SBAR(); \
            AT_PVM(vA, 3); l += sacc; SBAR(); } while (0)
#define AT_ENDSTEP(tt) do { AT_WAIT_BAR(); if ((tt) + 3 < NT) AT_DMA((tt) + 3, s0); { const int s_ = s0; s0 = s1; s1 = s2; s2 = s_; } } while (0)
    f32x16 pA0, pA1, pB0, pB1; u32x4 pw[4]; bf16x8 kA0, kA1, vA[4];
    int s0 = 0, s1 = STG, s2 = 2 * STG;
    AT_WAIT_BAR();
    AT_KRD(kA0, kA1, 0, 0); AT_QKZ(pA0, pA1, kA0, kA1);
#pragma unroll
    for (int d0 = 1; d0 < 4; ++d0) { AT_KRD(kA0, kA1, 0, d0); AT_QKM(pA0, pA1, kA0, kA1, d0); }
    for (int t = 0; t < NT - 2; t += 2) {
        AT_STEPF(pA0, pA1, pB0, pB1); AT_ENDSTEP(t);
        AT_STEPF(pB0, pB1, pA0, pA1); AT_ENDSTEP(t + 1);
    }
    if (myNT == NT) { AT_STEPF(pA0, pA1, pB0, pB1); AT_ENDSTEP(NT - 2); AT_STEPT(pB0, pB1); AT_ENDSTEP(NT - 1); }
    else { AT_STEPT(pA0, pA1); AT_ENDSTEP(NT - 2); AT_ENDSTEP(NT - 1); }
    asm volatile("" : "+v"(lane));
    const int r32e = lane & 31, hie = lane >> 5;
#define r32 r32e
#define hi hie
    const float lt = swapadd(l); const float inv = (c ? lam : 1.f) / lt;
    if (hi == 0) wsf[r32] = inv;
    AT_LWAIT();
    float invr[16];
#pragma unroll
    for (int r = 0; r < 16; ++r) invr[r] = wsf[crow(r, hi)];
    LAS float* X = (LAS float*)(L + qg * 16384);
    if (c == 1) {
#pragma unroll
        for (int db = 0; db < 4; ++db)
#pragma unroll
            for (int r = 0; r < 16; ++r) X[(db * 16 + r) * 64 + lane] = o[db][r] * invr[r];
    }
    AT_WAIT_BAR();
    if (c == 0) {
        float ss[16];
#pragma unroll
        for (int r = 0; r < 16; ++r) ss[r] = 0.f;
#pragma unroll
        for (int db = 0; db < 4; ++db)
#pragma unroll
            for (int r = 0; r < 16; ++r) { const float v = o[db][r] * invr[r] - X[(db * 16 + r) * 64 + lane]; o[db][r] = v; ss[r] += v * v; }
#pragma unroll
        for (int r = 0; r < 16; ++r) {
#pragma unroll
            for (int s = 1; s < 32; s <<= 1) ss[r] += __shfl_xor(ss[r], s);
            ss[r] = oml / sqrtf(ss[r] * (1.f / 128.f) + EPS); }
        AT_LWAIT();
        LAS bf16* stg = (LAS bf16*)(L + qg * 16384);
#pragma unroll
        for (int db = 0; db < 4; ++db) { const float g = subg[db * 32 + r32];
#pragma unroll
            for (int r = 0; r < 16; ++r) stg[crow(r, hi) * 128 + db * 32 + r32] = (bf16)f2bf(o[db][r] * ss[r] * g); }
        AT_LWAIT();
#pragma unroll
        for (int i = 0; i < 8; ++i) { const int row = i * 4 + (lane >> 4), ch = lane & 15; const u32x4 v = *(const LAS u32x4*)(stg + row * 128 + ch * 8);
            *(u32x4*)(O + (qrow + row) * D + head * 128 + ch * 8) = v; }
    }
    AT_WAIT_BAR();
#undef r32
#undef hi
#undef AT_DMA
#undef AT_KRD
#undef AT_VRD
#undef AT_QKM
#undef AT_QKZ
#undef AT_PVM
#undef AT_CHUNK
#undef AT_ROWMAX
#undef AT_DECIDE
#undef AT_ZERO
#undef AT_STEPF
#undef AT_STEPT
#undef AT_ENDSTEP
#undef SBAR
}
#undef AT_WAIT_BAR
#undef AT_LWAIT
}

__device__ __forceinline__ void ssm_const_group(const Params& p, int g, float* sm, int tid) {
    float (*POWr)[17] = (float (*)[17])sm; float (*POWi)[17] = (float (*)[17])(sm + SP * 17);
    float (*BBr)[SH] = (float (*)[SH])(sm + 2 * SP * 17); float (*BBi)[SH] = (float (*)[SH])(sm + 2 * SP * 17 + SP * SH);
    float* KT = sm + 2 * SP * 17 + 2 * SP * SH;
    const float *lam_re = p.in[5], *lam_im = p.in[6], *log_dt = p.in[7], *b_re = p.in[8], *b_im = p.in[9], *c_re = p.in[10], *c_im = p.in[11], *dsk = p.in[12];
    const double dt = exp((double)log_dt[g]);
    for (int i = tid; i < SP * 17; i += 512) { const int pp = i / 17, k = i % 17; const double re = lam_re[g * SP + pp], im = lam_im[g * SP + pp];
        const double mag = exp(re * dt * k), ang = im * dt * k; POWr[pp][k] = (float)(mag * cos(ang)); POWi[pp][k] = (float)(mag * sin(ang)); }
    for (int i = tid; i < SP * SH; i += 512) { const int pp = i / SH, h = i % SH; const double re = lam_re[g * SP + pp], im = lam_im[g * SP + pp];
        const double mag = exp(re * dt), ang = im * dt; const double lr = mag * cos(ang) - 1.0, li = mag * sin(ang);
        const double den = re * re + im * im; const double cr = (lr * re + li * im) / den, ci = (li * re - lr * im) / den;
        const double br = b_re[(g * SP + pp) * SH + h], bi = b_im[(g * SP + pp) * SH + h];
        BBr[pp][h] = (float)(cr * br - ci * bi); BBi[pp][h] = (float)(cr * bi + ci * br); }
    __syncthreads();
    for (int i = tid; i < 4096; i += 512) { const int tau = i >> 8, ho = (i >> 4) & 15, hi = i & 15; float s = 0.f;
        for (int pp = 0; pp < SP; ++pp) { const float cr = c_re[(g * SH + ho) * SP + pp], ci = c_im[(g * SH + ho) * SP + pp];
            const float zr = POWr[pp][tau], zi = POWi[pp][tau]; const float czr = cr * zr - ci * zi, czi = cr * zi + ci * zr;
            s += czr * BBr[pp][hi] - czi * BBi[pp][hi]; }
        KT[i] = s; }
    if (tid < SP) { float* L16 = (float*)(p.ws + WS_CONST); L16[(g * SP + tid) * 2] = POWr[tid][16]; L16[(g * SP + tid) * 2 + 1] = POWi[tid][16]; }
    __syncthreads();
    bf16* MG = (bf16*)(p.ws + WS_MG) + (size_t)g * 128 * 256;
    for (int i = tid; i < 128 * 256; i += 512) { const int j = i >> 8, k = i & 255, ri = j >> 6, pp = j & 63, s = k >> 4, h = k & 15;
        const float zr = POWr[pp][15 - s], zi = POWi[pp][15 - s]; const float vr = zr * BBr[pp][h] - zi * BBi[pp][h], vi = zr * BBi[pp][h] + zi * BBr[pp][h];
        MG[i] = (bf16)f2bf(ri ? vi : vr); }
    bf16* TE = (bf16*)(p.ws + WS_TE) + (size_t)g * 256 * 384;
    for (int i = tid; i < 256 * 384; i += 512) { const int j = i / 384, k = i % 384, tt = j >> 4, ho = j & 15; float v;
        if (k < 256) { const int s = k >> 4, hi = k & 15; v = s <= tt ? KT[((tt - s) << 8) + (ho << 4) + hi] : 0.f; if (s == tt && hi == ho) v += dsk[g * SH + ho]; }
        else { const int kk = k - 256, ri = kk >> 6, pp = kk & 63; const float cr = c_re[(g * SH + ho) * SP + pp], ci = c_im[(g * SH + ho) * SP + pp];
            const float zr = POWr[pp][tt + 1], zi = POWi[pp][tt + 1]; v = ri ? -(cr * zi + ci * zr) : (cr * zr - ci * zi); }
        TE[i] = (bf16)f2bf(v); }
    __syncthreads();
}
__device__ __forceinline__ void misc_const(const Params& p, int i) {
    float* rc = (float*)(p.ws + WS_ROPE); float* rs = rc + SEQ * 32;
    if (i < SEQ * 32) { const int pos = i >> 5, f = i & 31; const float inv = (float)pow(10000.0, -(double)f / 32.0); const float ang = (float)pos * inv;
        rc[i] = (float)cos((double)ang); rs[i] = (float)sin((double)ang); }
    if (i == SEQ * 32) { double s1 = 0, s2 = 0; for (int d = 0; d < HD; ++d) { s1 += (double)p.in[15][d] * p.in[16][d]; s2 += (double)p.in[17][d] * p.in[18][d]; }
        const double lam_init = 0.8 - 0.6 * exp(-0.3 * 1.0); float* c = (float*)(p.ws + WS_CONST + 65536); c[0] = (float)(exp(s1) - exp(s2) + lam_init); c[1] = (float)(1.0 - lam_init); }
}

__device__ __forceinline__ void transpose_item(const float* W, int ldw, int scol0, bf16* WT, int K, int drow0, int k0, float* scr, int lane) {
#pragma unroll 8
    for (int i = 0; i < 32; ++i) { const int kk = 2 * i + (lane >> 5); scr[kk * 33 + (lane & 31)] = W[(size_t)(k0 + kk) * ldw + scol0 + (lane & 31)]; }
    asm volatile("s_waitcnt lgkmcnt(0)" ::: "memory");
    const int c = lane & 7;
#pragma unroll
    for (int j = 0; j < 4; ++j) { const int n = (lane >> 3) + 8 * j; const float* s = scr + (8 * c) * 33 + n;
        u32x4 o; o.x = pk2(s[0 * 33], s[1 * 33]); o.y = pk2(s[2 * 33], s[3 * 33]); o.z = pk2(s[4 * 33], s[5 * 33]); o.w = pk2(s[6 * 33], s[7 * 33]);
        *(u32x4*)(WT + (size_t)(drow0 + n) * K + k0 + 8 * c) = o; }
    asm volatile("s_waitcnt lgkmcnt(0)" ::: "memory");
}
constexpr int CI_WIN = 16 * 32, CI_GLU = 16 * 64, CI_QKV = 16 * 96, CI_WO = 16 * 32, CI_GU = 64 * 16 * 16, CI_WD = 64 * 4 * 32;
constexpr int CI_TOTAL = CI_WIN + CI_GLU + CI_QKV + CI_WO + CI_GU + CI_WD;
__device__ __forceinline__ void conv_item(const Params& p, int it, float* scr, int lane) {
    unsigned char* ws = p.ws;
    if (it < CI_WIN) { const int kb = it / 32, nb = it % 32; transpose_item(p.in[4], D, nb * 32, (bf16*)(ws + WS_WIN), D, nb * 32, kb * 64, scr, lane); return; } it -= CI_WIN;
    if (it < CI_GLU) { const int kb = it / 64, nb = it % 64; const int pn = nb >> 3, bj = (nb >> 2) & 1, i0 = (nb & 3) * 32;
        transpose_item(p.in[13], 2 * D, bj * D + pn * 128 + i0, (bf16*)(ws + WS_WGLU), D, nb * 32, kb * 64, scr, lane); return; } it -= CI_GLU;
    if (it < CI_QKV) { const int kb = it / 96, nb = it % 96; int sc = nb * 32; if (nb < 64) { const int pn = nb >> 3, bj = (nb >> 2) & 1, wc = nb & 3; sc = pn * 256 + wc * 64 + bj * 32; }
        transpose_item(p.in[14], 3 * D, sc, (bf16*)(ws + WS_WQKV), D, nb * 32, kb * 64, scr, lane); return; } it -= CI_QKV;
    if (it < CI_WO) { const int kb = it / 32, nb = it % 32; transpose_item(p.in[20], D, nb * 32, (bf16*)(ws + WS_WO), D, nb * 32, kb * 64, scr, lane); return; } it -= CI_WO;
    if (it < CI_GU) { const int le = it >> 8, r = it & 255, kb = r >> 4, nb = r & 15; const int pn = nb >> 3, bj = (nb >> 2) & 1, i0 = (nb & 3) * 32;
        const float* src = (bj ? p.in[26] : p.in[25]) + (size_t)le * D * FE;
        transpose_item(src, FE, pn * 128 + i0, (bf16*)(ws + WS_WGU) + (size_t)le * 512 * D, D, nb * 32, kb * 64, scr, lane); return; } it -= CI_GU;
    { const int le = it >> 7, r = it & 127, kb = r >> 5, nb = r & 31;
        transpose_item(p.in[27] + (size_t)le * FE * D, D, nb * 32, (bf16*)(ws + WS_WD) + (size_t)le * D * FE, FE, nb * 32, kb * 64, scr, lane); }
}

template <int MODE, bool DRY = false>
__device__ __forceinline__ void norm_row(const Params& p, int row, int lane) {
    unsigned char* ws = p.ws;
    const float* src = (MODE == 0) ? p.in[0] : p.out; const float* gain = MODE == 0 ? p.in[1] : MODE == 2 ? p.in[1] + D : p.in[3];
    const f32x4* xr = (const f32x4*)(src + (size_t)row * D) + lane;
    f32x4 v[4]; float s = 0.f;
#pragma unroll
    for (int j = 0; j < 4; ++j) v[j] = xr[64 * j];
    if (MODE == 2 || MODE == 4) {
        const bf16* C0 = (const bf16*)(ws + WS_R2) + (size_t)row * D, *C1 = C0 + (size_t)T * D;
#pragma unroll
        for (int j = 0; j < 4; ++j) { const uint2 a = *((const uint2*)C0 + lane + 64 * j), b = *((const uint2*)C1 + lane + 64 * j);
            v[j].x += bf2f(a.x & 0xffffu) + bf2f(b.x & 0xffffu); v[j].y += bf2f(a.x >> 16) + bf2f(b.x >> 16); v[j].z += bf2f(a.y & 0xffffu) + bf2f(b.y & 0xffffu); v[j].w += bf2f(a.y >> 16) + bf2f(b.y >> 16); }
        if (MODE == 2 && !DRY) {
#pragma unroll
            for (int j = 0; j < 4; ++j) ((f32x4*)(p.out + (size_t)row * D) + lane)[64 * j] = v[j]; }
    }
#pragma unroll
    for (int j = 0; j < 4; ++j) s += (v[j].x * v[j].x + v[j].y * v[j].y) + (v[j].z * v[j].z + v[j].w * v[j].w);
    const float rstd = 1.f / sqrtf(wave_sum(s) * (1.f / D) + EPS);
#pragma unroll
    for (int j = 0; j < 4; ++j) { const f32x4 g = ((const f32x4*)gain + lane)[64 * j]; v[j] = v[j] * rstd * g; }
    if (MODE == 4 && !DRY) {
#pragma unroll
        for (int j = 0; j < 4; ++j) ((f32x4*)(p.out + (size_t)row * D) + lane)[64 * j] = v[j];
        return; }
    uint2* o8 = (uint2*)((bf16*)(ws + WS_R1) + (size_t)row * D) + lane;
#pragma unroll
    for (int j = 0; j < 4; ++j) { uint2 o; o.x = pk2(v[j].x, v[j].y); o.y = pk2(v[j].z, v[j].w); o8[64 * j] = o; }
}

constexpr int WRE_LDS_OFF = 16384;
__device__ __forceinline__ void router_load_lds(const Params& p, int l, float* sm, int tid) {
    const float* wrg = p.in[21] + (size_t)l * D * 4; const float* wre = p.in[23] + (size_t)l * D * 32;
    for (int d = tid; d < D; d += 512) { const int rec = (((d >> 8) * 4 + (d & 3)) << 6) + ((d & 255) >> 2); *(f32x4*)(sm + rec * 4) = *(const f32x4*)(wrg + d * 4); }
    for (int q = tid; q < D * 8; q += 512) { const int d = q >> 3, gs = (q >> 1) & 3, hf = q & 1; const int rec = (((d >> 8) * 4 + (d & 3)) << 6) + ((d & 255) >> 2);
        *(f32x4*)(sm + WRE_LDS_OFF / 4 + ((size_t)(gs * 1024 + rec)) * 8 + hf * 4) = *(const f32x4*)(wre + d * 32 + gs * 8 + hf * 4); }
    __syncthreads();
}
__device__ __forceinline__ float reduce8(const float (&v)[8], int lane) {
    float w4[4], w2[2];
#pragma unroll
    for (int k = 0; k < 4; ++k) { const float send = (lane & 1) ? v[k] : v[k + 4], keep = (lane & 1) ? v[k + 4] : v[k]; w4[k] = keep + __shfl_xor(send, 1); }
#pragma unroll
    for (int k = 0; k < 2; ++k) { const float send = (lane & 2) ? w4[k] : w4[k + 2], keep = (lane & 2) ? w4[k + 2] : w4[k]; w2[k] = keep + __shfl_xor(send, 2); }
    const float send = (lane & 4) ? w2[0] : w2[1], keep = (lane & 4) ? w2[1] : w2[0];
    float w1 = keep + __shfl_xor(send, 4);
    w1 += __shfl_xor(w1, 8); w1 += __shfl_xor(w1, 16); w1 += __shfl_xor(w1, 32);
    return w1;
}
#define R8LANE(k) ((((k) >> 2) & 1) | ((((k) >> 1) & 1) << 1) | (((k) & 1) << 2))
#define R8GET(w, k) __builtin_bit_cast(float, __builtin_amdgcn_readlane(__builtin_bit_cast(int, (w)), R8LANE(k)))
struct RouteOut { int ge0, ge1; float w0, w1; };
template <int l>
__device__ __forceinline__ RouteOut norm_route_row(const Params& p, int row, int lane, const float* sm) {
    unsigned char* ws = p.ws;
    const float* gain = p.in[2] + l * D; const float* brg = p.in[22] + l * 4; const float* bre = p.in[24] + l * 32;
    const f32x4* xr = (const f32x4*)(p.out + (size_t)row * D) + lane;
    f32x4 v[4];
#pragma unroll
    for (int j = 0; j < 4; ++j) v[j] = xr[64 * j];
    float pv[8] = {0.f, 0.f, 0.f, 0.f, 0.f, 0.f, 0.f, 0.f};
#pragma unroll
    for (int j = 0; j < 4; ++j) { pv[0] += (v[j].x * v[j].x + v[j].y * v[j].y) + (v[j].z * v[j].z + v[j].w * v[j].w);
        const f32x4 g = ((const f32x4*)gain + lane)[64 * j]; v[j] = v[j] * g;
        const float xv[4] = {v[j].x, v[j].y, v[j].z, v[j].w};
#pragma unroll
        for (int i = 0; i < 4; ++i) { const f32x4 w = *(const f32x4*)(sm + (((j * 4 + i) << 6) + lane) * 4); pv[1] += xv[i] * w.x; pv[2] += xv[i] * w.y; pv[3] += xv[i] * w.z; pv[4] += xv[i] * w.w; } }
    const float r1 = reduce8(pv, lane);
    const float rstd = 1.f / sqrtf(R8GET(r1, 0) * (1.f / D) + EPS);
    const float gl[4] = {R8GET(r1, 1) * rstd, R8GET(r1, 2) * rstd, R8GET(r1, 3) * rstd, R8GET(r1, 4) * rstd};
    uint2* o8 = (uint2*)((bf16*)(ws + WS_R1) + (size_t)row * D) + lane;
#pragma unroll
    for (int j = 0; j < 4; ++j) { uint2 o; o.x = pk2(v[j].x * rstd, v[j].y * rstd); o.y = pk2(v[j].z * rstd, v[j].w * rstd); o8[64 * j] = o; }
    int gs = 0; float best = gl[0] + brg[0];
#pragma unroll
    for (int i = 1; i < 4; ++i) { const float c = gl[i] + brg[i]; if (c > best) { best = c; gs = i; } }
    const float gm = fmaxf(fmaxf(gl[0], gl[1]), fmaxf(gl[2], gl[3])); float gsum = 0.f, gsel = 0.f;
#pragma unroll
    for (int i = 0; i < 4; ++i) { const float e = __expf(gl[i] - gm); gsum += e; if (i == gs) gsel = e; }
    const float g_w = gsel / gsum;
    float pe[8] = {0.f, 0.f, 0.f, 0.f, 0.f, 0.f, 0.f, 0.f};
    const float* we = sm + WRE_LDS_OFF / 4 + (size_t)gs * 1024 * 8;
#pragma unroll
    for (int j = 0; j < 4; ++j) { const float xv[4] = {v[j].x, v[j].y, v[j].z, v[j].w};
#pragma unroll
        for (int i = 0; i < 4; ++i) { const float* wp = we + (((j * 4 + i) << 6) + lane) * 8; const f32x4 w0 = *(const f32x4*)wp, w1 = *(const f32x4*)(wp + 4);
            pe[0] += xv[i] * w0.x; pe[1] += xv[i] * w0.y; pe[2] += xv[i] * w0.z; pe[3] += xv[i] * w0.w; pe[4] += xv[i] * w1.x; pe[5] += xv[i] * w1.y; pe[6] += xv[i] * w1.z; pe[7] += xv[i] * w1.w; } }
    const float r2 = reduce8(pe, lane);
    float el[8] = {R8GET(r2, 0) * rstd, R8GET(r2, 1) * rstd, R8GET(r2, 2) * rstd, R8GET(r2, 3) * rstd, R8GET(r2, 4) * rstd, R8GET(r2, 5) * rstd, R8GET(r2, 6) * rstd, R8GET(r2, 7) * rstd};
    float em = el[0];
#pragma unroll
    for (int i = 1; i < 8; ++i) em = fmaxf(em, el[i]);
    float ep[8], esum = 0.f;
#pragma unroll
    for (int i = 0; i < 8; ++i) { ep[i] = __expf(el[i] - em); esum += ep[i]; }
    int e0 = 0, e1 = 0; float b0 = -1e30f, b1 = -1e30f;
#pragma unroll
    for (int i = 0; i < 8; ++i) { ep[i] /= esum; const float c = ep[i] + bre[gs * 8 + i]; if (c > b0) { b0 = c; e0 = i; } }
#pragma unroll
    for (int i = 0; i < 8; ++i) { const float c = ep[i] + bre[gs * 8 + i]; if (i != e0 && c > b1) { b1 = c; e1 = i; } }
    float p0 = 0.f, p1 = 0.f;
#pragma unroll
    for (int i = 0; i < 8; ++i) { if (i == e0) p0 = ep[i]; if (i == e1) p1 = ep[i]; }
    RouteOut ro; ro.ge0 = gs * 8 + e0; ro.ge1 = gs * 8 + e1; ro.w0 = p0 / (p0 + p1) * g_w; ro.w1 = p1 / (p0 + p1) * g_w;
    return ro;
}
template <int l, bool DRY = false>
__device__ __forceinline__ void norm_route_phase(const Params& p, const float* sm, int gw, int NGW, int lane) {
    unsigned char* ws = p.ws;
    unsigned* cnt = (unsigned*)(ws + WS_CTL) + CW_CNT + l * NE * 64; int* list = (int*)(ws + WS_LIST); float* wl = (float*)(ws + WS_LIST + 4 * MiB);
    int nb = 0, mrow = 0, mg0 = 0, mg1 = 0; float mw0 = 0.f, mw1 = 0.f;
    for (int row = gw; row < T; row += NGW) {
        const RouteOut ro = norm_route_row<l>(p, row, lane, sm);
        if (lane == nb) { mrow = row; mg0 = ro.ge0; mg1 = ro.ge1; mw0 = ro.w0; mw1 = ro.w1; }
        if (++nb == 64 || row + NGW >= T) {
            if (!DRY && lane < nb) { const unsigned q0 = atomicAdd(cnt + mg0 * 64, 1u); const unsigned q1 = atomicAdd(cnt + mg1 * 64, 1u);
                list[(size_t)mg0 * T + q0] = mrow * 2; wl[(size_t)mg0 * T + q0] = mw0; list[(size_t)mg1 * T + q1] = mrow * 2 + 1; wl[(size_t)mg1 * T + q1] = mw1; }
            nb = 0; }
    }
}

__device__ __forceinline__ void scan_block(const Params& p, int item, float* sm, int wave, int lane) {
    const int b = item >> 6, g = item & 63;
    const float* L16 = (const float*)(p.ws + WS_CONST) + (g * SP + lane) * 2; const float ar = L16[0], ai = L16[1];
    const float* SL = (const float*)(p.ws + WS_R3) + ((size_t)g * NCR + (size_t)b * 256 + wave * 32) * 128;
    bf16* UX = (bf16*)(p.ws + WS_R2) + ((size_t)g * NCR + (size_t)b * 256 + wave * 32) * UXP + 256;
    float lr[32], li[32];
#pragma unroll
    for (int c = 0; c < 32; ++c) { lr[c] = SL[(size_t)c * 128 + lane]; li[c] = SL[(size_t)c * 128 + 64 + lane]; }
    float er = 0.f, ei = 0.f;
#pragma unroll
    for (int c = 0; c < 32; ++c) { const float nr = ar * er - ai * ei + lr[c], ni = ar * ei + ai * er + li[c]; er = nr; ei = ni; }
    sm[(wave * 64 + lane) * 2] = er; sm[(wave * 64 + lane) * 2 + 1] = ei;
    float a32r = ar, a32i = ai;
#pragma unroll
    for (int k = 0; k < 5; ++k) { const float nr = a32r * a32r - a32i * a32i, ni = 2.f * a32r * a32i; a32r = nr; a32i = ni; }
    __syncthreads();
    float sr = 0.f, si = 0.f;
    for (int v = 0; v < wave; ++v) { const float pr = sm[(v * 64 + lane) * 2], pi = sm[(v * 64 + lane) * 2 + 1]; const float nr = a32r * sr - a32i * si + pr, ni = a32r * si + a32i * sr + pi; sr = nr; si = ni; }
#pragma unroll
    for (int c = 0; c < 32; ++c) {
        UX[(size_t)c * UXP + lane] = (bf16)f2bf(sr); UX[(size_t)c * UXP + 64 + lane] = (bf16)f2bf(si);
        const float nr = ar * sr - ai * si + lr[c], ni = ar * si + ai * sr + li[c]; sr = nr; si = ni;
    }
    __syncthreads();
}

#define XB_TMO      128
#define XB_XCNT(j)  (256  + 64 * (j))
#define XB_XSUB(j)  (1280 + 64 * (j))
#define XB_XGEN(j)  (2304 + 64 * (j))
#define XB_TOP      3328
#define XB_TOPGEN   3392
#define XCD_BAR_WORDS 3456
#define XB_SPIN_CAP (1u << 18)
__device__ __forceinline__ unsigned xb_ld(unsigned* p)              { return __hip_atomic_load(p, __ATOMIC_RELAXED, __HIP_MEMORY_SCOPE_AGENT); }
__device__ __forceinline__ unsigned xb_add(unsigned* p, unsigned v) { return __hip_atomic_fetch_add(p, v, __ATOMIC_RELAXED, __HIP_MEMORY_SCOPE_AGENT); }
__device__ __forceinline__ unsigned xb_xcc_id() { return (unsigned)__builtin_amdgcn_s_getreg((3 << 11) | 20) & 0xFu; }
#define XB_SPIN(cond, bar) do { unsigned _sp = 0; while (cond) { __builtin_amdgcn_s_sleep(1); \
    if ((++_sp & 255u) == 0u) { if (xb_ld(&(bar)[XB_TMO])) break; if (_sp > XB_SPIN_CAP) { atomicAdd(&(bar)[XB_TMO], 1u); break; } } } } while (0)
struct XcdBarrier { unsigned* bar; unsigned x; volatile LAS unsigned* st; };
__device__ __forceinline__ XcdBarrier xcd_barrier_post(unsigned* bar, volatile LAS unsigned* st) {
    XcdBarrier b; b.bar = bar; b.x = xb_xcc_id(); b.st = st;
    if (threadIdx.x == 0) (void)xb_add(&bar[XB_XCNT(b.x)], 1u);
    return b;
}
__device__ __forceinline__ void xcd_barrier_complete(unsigned* bar, unsigned x, unsigned& nloc, unsigned& nx) {
    const unsigned G = gridDim.x * gridDim.y * gridDim.z;
    unsigned sum, cnt, mine, sp = 0u;
    for (;;) {
        sum = 0u; cnt = 0u; mine = 0u;
#pragma unroll
        for (unsigned j = 0; j < 16; ++j) { const unsigned c = xb_ld(&bar[XB_XCNT(j)]); sum += c; cnt += (c > 0u) ? 1u : 0u; mine = (j == x) ? c : mine; }
        if (sum == G) break;
        __builtin_amdgcn_s_sleep(1);
        if ((++sp & 255u) == 0u) { if (xb_ld(&bar[XB_TMO])) break; if (sp > XB_SPIN_CAP) { atomicAdd(&bar[XB_TMO], 1u); break; } }
    }
    nloc = mine > 0u ? mine : 1u; nx = cnt > 0u ? cnt : 1u;
}
__device__ __forceinline__ void xcd_barrier(const XcdBarrier& b) {
    asm volatile("s_waitcnt vmcnt(0)" ::: "memory");
    __syncthreads();
    if (threadIdx.x == 0) {
        unsigned* bar = b.bar;
        __builtin_amdgcn_s_waitcnt(0);
        unsigned nloc = b.st[0], nx = b.st[1];
        if (nloc == 0u) { xcd_barrier_complete(bar, b.x, nloc, nx); b.st[0] = nloc; b.st[1] = nx; }
        const unsigned old = xb_add(&bar[XB_XSUB(b.x)], 1u);
        const unsigned gen = old / nloc;
        if (old + 1u == (gen + 1u) * nloc) {
            __builtin_amdgcn_fence(__ATOMIC_RELEASE, "agent");
            asm volatile("s_waitcnt vmcnt(0)" ::: "memory");
            const unsigned og = xb_add(&bar[XB_TOP], 1u);
            const unsigned tg = og / nx;
            if (og + 1u == (tg + 1u) * nx) xb_add(&bar[XB_TOPGEN], 1u);
            else XB_SPIN(xb_ld(&bar[XB_TOPGEN]) == tg, bar);
            __builtin_amdgcn_fence(__ATOMIC_ACQUIRE, "agent");
            xb_add(&bar[XB_XGEN(b.x)], 1u);
            asm volatile("s_waitcnt vmcnt(0)" ::: "memory");
        } else {
            XB_SPIN(xb_ld(&bar[XB_XGEN(b.x)]) == gen, bar);
            __builtin_amdgcn_fence(__ATOMIC_ACQUIRE, "agent");
            asm volatile("s_waitcnt vmcnt(0)" ::: "memory");
        }
    }
    __syncthreads();
}

constexpr int NPHASE = 17;
#ifndef PROBE_DUP
#define PROBE_DUP 0
#endif
#define REPS(k) for (int rep_ = 0; rep_ < (((PROBE_DUP >> (k)) & 1) ? 2 : 1); ++rep_)
#ifndef ATTN_THR
#define ATTN_THR 8
#endif
struct Args { Params p; int ph_lo, ph_hi, li, pad; };

__device__ __forceinline__ void moe_setup(LAS int* tab, unsigned* cnt, int tid) {
    if (tid < NE) tab[64 + tid] = (int)__hip_atomic_load(cnt + tid * 64, __ATOMIC_RELAXED, __HIP_MEMORY_SCOPE_AGENT);
    __syncthreads();
    if (tid == 0) { int pf = 0; for (int e = 0; e < NE; ++e) { tab[e] = pf; pf += (tab[64 + e] + 255) >> 8; } tab[32] = pf; }
    __syncthreads();
}

__global__ void __launch_bounds__(512, 2) fwd(Args args) {
    extern __shared__ __attribute__((aligned(16))) unsigned char lds[];
    const Params& p = args.p; unsigned char* ws = p.ws;
    LAS unsigned char* L = (LAS unsigned char*)lds;
    const int G = gridDim.x, bid = blockIdx.x, NGW = G * 8;
#define PHASE_IDS() int tid = threadIdx.x; asm volatile("" : "+v"(tid)); const int lane = tid & 63, wave = __builtin_amdgcn_readfirstlane(tid >> 6), gw = bid * 8 + wave; (void)lane; (void)gw
    volatile LAS unsigned* MISC = (volatile LAS unsigned*)(L + MISC_OFF);
    LAS int* tab = (LAS int*)(L + TAB_OFF);
    for (int u = threadIdx.x; u < (LDS_BYTES - TAB_OFF) / 4; u += 512) ((LAS unsigned*)(L + TAB_OFF))[u] = 0u;
    __syncthreads();
    unsigned* ctl = (unsigned*)(ws + WS_CTL);
    const int lo = args.ph_lo, hi = args.ph_hi;
    const bool multi = (hi - lo) > 1;
    XcdBarrier bar; bar.bar = ctl + CW_BAR + args.li * XCD_BAR_WORDS; bar.x = 0; bar.st = nullptr;
    if (multi) bar = xcd_barrier_post(ctl + CW_BAR + args.li * XCD_BAR_WORDS, MISC + 8);
#define IN(k) (lo <= (k) && (k) < hi)
#define SEAM(k) do { if (IN(k) && IN((k) + 1)) xcd_barrier(bar); } while (0)
    bf16 *H = (bf16*)(ws + WS_R1), *Gm = (bf16*)(ws + WS_R1), *UX = (bf16*)(ws + WS_R2), *Qb = (bf16*)(ws + WS_R2), *KIMG = Qb + (size_t)T * D, *CBUF = (bf16*)(ws + WS_R2);
    bf16 *VIMG = (bf16*)(ws + WS_R3), *HID = (bf16*)(ws + WS_R3); float* SLOC = (float*)(ws + WS_R3);
    const int* list = (const int*)(ws + WS_LIST); const float* wl = (const float*)(ws + WS_LIST + 4 * MiB);

    if (IN(0)) REPS(0) { PHASE_IDS();
        if (bid < SG) ssm_const_group(p, bid, (float*)lds, tid);
        for (int i = (G - 1 - bid) * 512 + tid; i <= SEQ * 32; i += G * 512) misc_const(p, i);
        float* scr = (float*)(lds + 40960 + wave * 8448);
        for (int it = gw; it < CI_TOTAL; it += NGW) conv_item(p, it, scr, lane);
        for (int row = gw; row < T; row += NGW) norm_row<0>(p, row, lane);
        __syncthreads();
    }
    SEAM(0);
    if (IN(1)) REPS(1) { SchedDense s{H, (const bf16*)(ws + WS_WIN), 4, D, 0, 0}; EpiWin e{UX}; pg::gemm_phase<SchedDense, EpiWin, true>(L, s, e, G, bid, tab); }
    SEAM(1);
    if (IN(2)) REPS(2) { SchedSsm s{UX, (const bf16*)(ws + WS_MG), 256, 128}; EpiSsmA e{SLOC}; pg::gemm_phase<SchedSsm, EpiSsmA, true>(L, s, e, G, bid, tab); }
    SEAM(2);
    if (IN(3)) REPS(3) { PHASE_IDS(); for (int it = bid; it < NB * SG; it += G) scan_block(p, it, (float*)lds, wave, lane); }
    SEAM(3);
    if (IN(4)) REPS(4) { SchedSsm s{UX, (const bf16*)(ws + WS_TE), 384, 256}; EpiSsmC e{Gm}; pg::gemm_phase<SchedSsm, EpiSsmC, true>(L, s, e, G, bid, tab); }
    SEAM(4);
    if (IN(5)) REPS(5) { SchedDense s{Gm, (const bf16*)(ws + WS_WGLU), 8, D, 1, 0}; EpiGlu e{p.in[0], p.out}; pg::gemm_phase<SchedDense, EpiGlu, true>(L, s, e, G, bid, tab); }
    SEAM(5);
    if (IN(6)) { PHASE_IDS(); router_load_lds(p, 0, (float*)lds, tid); if ((PROBE_DUP >> 6) & 1) norm_route_phase<0, true>(p, (const float*)lds, gw, NGW, lane); norm_route_phase<0>(p, (const float*)lds, gw, NGW, lane); __syncthreads(); }
    SEAM(6);
    if (IN(7)) REPS(7) { PHASE_IDS(); moe_setup(tab, ctl + CW_CNT, tid);
        SchedMoe<1> s{H, (const bf16*)(ws + WS_WGU), list, 0, 1024, 0}; EpiMoe1 e{HID, wl}; pg::gemm_phase<SchedMoe<1>, EpiMoe1, true>(L, s, e, G, bid, tab); }
    SEAM(7);
    if (IN(8)) REPS(8) { PHASE_IDS(); moe_setup(tab, ctl + CW_CNT, tid);
        SchedMoe<2> s{HID, (const bf16*)(ws + WS_WD), list, 0, 256, 0}; EpiMoe2 e{CBUF, list}; pg::gemm_phase<SchedMoe<2>, EpiMoe2, true>(L, s, e, G, bid, tab); }
    SEAM(8);
    if (IN(9)) { PHASE_IDS(); if ((PROBE_DUP >> 9) & 1) for (int row = gw; row < T; row += NGW) norm_row<2, true>(p, row, lane); for (int row = gw; row < T; row += NGW) norm_row<2>(p, row, lane); }
    SEAM(9);
    if (IN(10)) REPS(10) { SchedDense s{H, (const bf16*)(ws + WS_WQKV), 12, D, 0, 0}; EpiQkv e{Qb, KIMG, VIMG, (const float*)(ws + WS_ROPE), (const float*)(ws + WS_ROPE) + SEQ * 32};
        pg::gemm_phase<SchedDense, EpiQkv, true>(L, s, e, G, bid, tab); }
    SEAM(10);
    if (IN(11)) { PHASE_IDS(); const float* cst = (const float*)(ws + WS_CONST + 65536); const float lam = cst[0], oml = cst[1];
        const int vcu = (G % 8 == 0) ? (bid % 8) * (G / 8) + bid / 8 : bid;
        REPS(11) { bf16* Oo = (((PROBE_DUP >> 11) & 1) && rep_ == 0) ? H : Qb;
        for (int pr = vcu; pr < NB * NH * 16; pr += G) { const int bh = pr >> 4, s = pr & 15;
#pragma unroll 1
            for (int k2 = 0; k2 < 2; ++k2) at::attn_unit<ATTN_THR>(Qb, KIMG, VIMG, Oo, p.in[19], lam, oml, bh, k2 ? s : 31 - s, L, wave, lane); } } }
    SEAM(11);
    if (IN(12)) { SchedDense s{Qb, (const bf16*)(ws + WS_WO), 4, D, 0, 0}; EpiWo e{p.out}; pg::gemm_phase<SchedDense, EpiWo, true>(L, s, e, G, bid, tab); }
    SEAM(12);
    if (IN(13)) { PHASE_IDS(); router_load_lds(p, 1, (float*)lds, tid); if ((PROBE_DUP >> 13) & 1) norm_route_phase<1, true>(p, (const float*)lds, gw, NGW, lane); norm_route_phase<1>(p, (const float*)lds, gw, NGW, lane); __syncthreads(); }
    SEAM(13);
    if (IN(14)) REPS(14) { PHASE_IDS(); moe_setup(tab, ctl + CW_CNT + NE * 64, tid);
        SchedMoe<1> s{H, (const bf16*)(ws + WS_WGU) + (size_t)NE * 512 * D, list, 0, 1024, 0}; EpiMoe1 e{HID, wl}; pg::gemm_phase<SchedMoe<1>, EpiMoe1, true>(L, s, e, G, bid, tab); }
    SEAM(14);
    if (IN(15)) REPS(15) { PHASE_IDS(); moe_setup(tab, ctl + CW_CNT + NE * 64, tid);
        SchedMoe<2> s{HID, (const bf16*)(ws + WS_WD) + (size_t)NE * D * FE, list, 0, 256, 0}; EpiMoe2 e{CBUF, list}; pg::gemm_phase<SchedMoe<2>, EpiMoe2, true>(L, s, e, G, bid, tab); }
    SEAM(15);
    if (((PROBE_DUP >> 20) & 1) && IN(15) && IN(16)) { for (int k = 0; k < 16; ++k) xcd_barrier(bar); }
    if (IN(16)) { PHASE_IDS(); if ((PROBE_DUP >> 16) & 1) for (int row = gw; row < T; row += NGW) norm_row<4, true>(p, row, lane); for (int row = gw; row < T; row += NGW) norm_row<4>(p, row, lane); }
#undef IN
#undef SEAM
#undef PHASE_IDS
}

__global__ void __launch_bounds__(256) k_naive_attn(Params p) {
    __shared__ float ssq[64][4];
    const int blk = blockIdx.x, qc = blk & 63, bh = blk >> 6, b = bh >> 3, head = bh & 7;
    const int q = threadIdx.x >> 2, eg = threadIdx.x & 3;
    const bf16* Q = (const bf16*)(p.ws + WS_R2); const bf16* KIMG = Q + (size_t)T * D; const bf16* VIMG = (const bf16*)(p.ws + WS_R3);
    const float* cst = (const float*)(p.ws + WS_CONST + 65536); const float lam = cst[0], oml = cst[1];
    const size_t t = (size_t)b * SEQ + qc * 64 + q;
    float q0[64], q1[64];
#pragma unroll
    for (int d = 0; d < 64; d += 8) { unpack8(*(const u32x4*)(Q + t * D + head * 128 + d), q0 + d); unpack8(*(const u32x4*)(Q + t * D + head * 128 + 64 + d), q1 + d); }
    float a0[32], a1[32];
#pragma unroll
    for (int i = 0; i < 32; ++i) { a0[i] = 0.f; a1[i] = 0.f; }
    float m0 = -1e30f, m1 = -1e30f, l0 = 0.f, l1 = 0.f;
    const int nk = (qc + 1) * 64;
    for (int key = 0; key < nk; ++key) {
        const bf16* kb = KIMG + ((size_t)bh * 64 + (key >> 6)) * 8192 + (key & 63) * 8;
        float s0 = 0.f, s1 = 0.f;
#pragma unroll
        for (int ch = 0; ch < 8; ++ch) { float kv[8]; unpack8(*(const u32x4*)(kb + ch * 512), kv);
#pragma unroll
            for (int i = 0; i < 8; ++i) s0 += q0[ch * 8 + i] * kv[i];
            unpack8(*(const u32x4*)(kb + (8 + ch) * 512), kv);
#pragma unroll
            for (int i = 0; i < 8; ++i) s1 += q1[ch * 8 + i] * kv[i]; }
        const bf16* vb = VIMG + ((size_t)bh * 64 + (key >> 6)) * 8192 + eg * 2048 + ((key & 63) >> 4) * 512 + (key & 15) * 32;
        float vv[32];
#pragma unroll
        for (int i = 0; i < 32; i += 8) unpack8(*(const u32x4*)(vb + i), vv + i);
        if (s0 > m0) { const float f = exp2f(m0 - s0); l0 *= f;
#pragma unroll
            for (int i = 0; i < 32; ++i) a0[i] *= f;
            m0 = s0; }
        if (s1 > m1) { const float f = exp2f(m1 - s1); l1 *= f;
#pragma unroll
            for (int i = 0; i < 32; ++i) a1[i] *= f;
            m1 = s1; }
        const float p0 = exp2f(s0 - m0), p1 = exp2f(s1 - m1); l0 += p0; l1 += p1;
#pragma unroll
        for (int i = 0; i < 32; ++i) { a0[i] += p0 * vv[i]; a1[i] += p1 * vv[i]; }
    }
    float o[32], ss = 0.f; const float r0 = 1.f / l0, r1 = lam / l1;
#pragma unroll
    for (int i = 0; i < 32; ++i) { o[i] = a0[i] * r0 - a1[i] * r1; ss += o[i] * o[i]; }
    ssq[q][eg] = ss; __syncthreads();
    const float tot = ssq[q][0] + ssq[q][1] + ssq[q][2] + ssq[q][3]; const float rs = 1.f / sqrtf(tot * (1.f / 128.f) + EPS) * oml;
    const float* sg = p.in[19];
    float ov[32];
#pragma unroll
    for (int i = 0; i < 32; ++i) ov[i] = o[i] * rs * sg[eg * 32 + i];
    bf16* O = (bf16*)(p.ws + WS_R2) + t * D + head * 128 + eg * 32;
#pragma unroll
    for (int i = 0; i < 32; i += 8) *(u32x4*)(O + i) = pack8(ov + i);
}

#ifndef LAUNCH_MODE
#define LAUNCH_MODE 2
#endif
extern "C" void kernel_launch(void* const* d_in, const int* in_sizes, int n_in, void* d_out, int out_size, void* d_ws, size_t ws_size, hipStream_t stream) {
    static int grid = 0;
    if (grid == 0) {
        if (n_in != 28 || out_size != T * D || ws_size < WS_END) { fprintf(stderr, "kernel_launch: unexpected shapes n_in %d out %d ws %zu\n", n_in, out_size, ws_size); grid = -1; return; }
        int dev = 0, cus = 0;
        if (hipGetDevice(&dev) != hipSuccess || hipDeviceGetAttribute(&cus, hipDeviceAttributeMultiprocessorCount, dev) != hipSuccess) { grid = -1; return; }
        if (hipFuncSetAttribute((const void*)fwd, hipFuncAttributeMaxDynamicSharedMemorySize, LDS_BYTES) != hipSuccess) { fprintf(stderr, "kernel_launch: hipFuncSetAttribute failed\n"); grid = -1; return; }
        int per_cu = 0; (void)hipOccupancyMaxActiveBlocksPerMultiprocessor(&per_cu, (const void*)fwd, 512, LDS_BYTES); (void)hipGetLastError();
        if (per_cu < 1) fprintf(stderr, "kernel_launch: occupancy query says %d\n", per_cu);
        grid = cus;
    }
    if (grid < 0) return;
    Args a{}; for (int i = 0; i < 28; ++i) a.p.in[i] = (const float*)d_in[i]; a.p.out = (float*)d_out; a.p.ws = (unsigned char*)d_ws;
    (void)hipMemsetAsync((char*)d_ws + WS_CTL, 0, CTL_ZERO_BYTES, stream);
    auto run = [&](int lo, int hi, int li) { a.ph_lo = lo; a.ph_hi = hi; a.li = li; hipLaunchKernelGGL(fwd, dim3(grid), dim3(512), LDS_BYTES, stream, a); };
#if LAUNCH_MODE == 0
    for (int ph = 0; ph < NPHASE; ++ph) { if (ph == 11) hipLaunchKernelGGL(k_naive_attn, dim3(NB * NH * 64), dim3(256), 0, stream, a.p); else run(ph, ph + 1, 0); }
#elif LAUNCH_MODE == 1
    run(0, 11, 0); hipLaunchKernelGGL(k_naive_attn, dim3(NB * NH * 64), dim3(256), 0, stream, a.p); run(12, 17, 1);
#else
    run(0, NPHASE, 0);
#endif
}
```
